# Optimizing an MI355X kernel written in HIP

```python
import numpy as np
import jax
import jax.numpy as jnp
from jax import lax

D_MODEL = 1024
BATCH = 2
SEQ = 8192
DEPTH = 4

N_A_LAYERS = DEPTH // 2
N_B_LAYERS = DEPTH - N_A_LAYERS
ALPHA = (2.0 * DEPTH) ** 0.25
BETA = (8.0 * DEPTH) ** -0.25
LN_EPS = 1e-5
NEG_INF = -1e30

RET_HEADS = 4
RET_QK_DIM = D_MODEL // RET_HEADS
RET_V_DIM = 2 * D_MODEL // RET_HEADS
RET_CHUNK = 128
RET_IN = 2 * RET_HEADS * RET_QK_DIM + 2 * RET_HEADS * RET_V_DIM

NSA_HEADS = 16
NSA_GROUPS = 4
NSA_REP = NSA_HEADS // NSA_GROUPS
NSA_HEAD_DIM = D_MODEL // NSA_HEADS
N_BRANCH = 3
CMP_STRIDE = 16
CMP_LEN = 2 * CMP_STRIDE
CMP_HIDDEN = 256
SLC_BLOCK = 64
SLC_TOPK = 16
WINDOW = 512
Q_BLOCK = 128
FORCE_BONUS = 100.0
NSA_IN = NSA_HEADS * NSA_HEAD_DIM + NSA_HEADS * N_BRANCH
NSA_KV = N_BRANCH * 2 * NSA_GROUPS * NSA_HEAD_DIM

PEER_HEADS = 8
PEER_NKEYS = 128
PEER_EXPERTS = PEER_NKEYS * PEER_NKEYS
PEER_TOPK = 16
PEER_QDIM = 256
PEER_TOKENS = 128

kernel_name = "yoco_retention_nsa_peer_deepnorm_adaln"


def layer_norm(x, g, b):
    xf = x.astype(jnp.float32)
    mu = jnp.mean(xf, axis=-1, keepdims=True)
    var = jnp.mean(jnp.square(xf - mu), axis=-1, keepdims=True)
    return ((xf - mu) * lax.rsqrt(var + LN_EPS) * g + b).astype(x.dtype)


def masked_softmax(s, mask):
    s = jnp.where(mask, s, NEG_INF)
    m = jnp.max(s, axis=-1, keepdims=True)
    e = jnp.where(mask, jnp.exp(s - m), 0.0)
    return e / jnp.maximum(jnp.sum(e, axis=-1, keepdims=True), 1e-30)


def rotate(x, cos, sin):
    x1, x2 = jnp.split(x, 2, axis=-1)
    return jnp.concatenate([x1 * cos - x2 * sin, x1 * sin + x2 * cos], axis=-1)


def retention(h, w_in, w_o):
    B, S, _ = h.shape
    H, dk, dv, C = RET_HEADS, RET_QK_DIM, RET_V_DIM, RET_CHUNK
    f32 = jnp.float32
    proj = h @ w_in
    q, k, v, g = jnp.split(proj, [H * dk, 2 * H * dk, 2 * H * dk + H * dv], axis=-1)
    to_heads = lambda t, d: t.reshape(B, S, H, d).transpose(0, 2, 1, 3).astype(f32)
    q, k, v = to_heads(q, dk), to_heads(k, dk), to_heads(v, dv)
    pos = jnp.arange(S, dtype=f32)
    theta = 1.0 / (10000.0 ** jnp.linspace(0.0, 1.0, dk // 2, dtype=f32))
    ang = pos[:, None] * theta[None, :]
    cos, sin = jnp.cos(ang), jnp.sin(ang)
    q = rotate(q, cos, sin)
    k = rotate(k, cos, sin) * (dk ** -0.5)
    log_g = jnp.log1p(-jnp.exp2(-5.0 - jnp.arange(H, dtype=f32)))
    idx = jnp.arange(C, dtype=f32)
    diff = idx[:, None] - idx[None, :]
    decay = jnp.where(diff >= 0, jnp.exp(jnp.maximum(diff, 0.0)[None] * log_g[:, None, None]), 0.0)
    q_dec = jnp.exp((idx + 1.0)[None] * log_g[:, None])
    k_dec = jnp.exp((C - 1.0 - idx)[None] * log_g[:, None])
    c_dec = jnp.exp(C * log_g)
    n_chunks = S // C
    chunks = lambda t: t.reshape(B, H, n_chunks, C, t.shape[-1]).transpose(2, 0, 1, 3, 4)

    def step(state, qkv):
        qc, kc, vc = qkv
        inner = jnp.einsum('bhqk,bhke->bhqe', jnp.einsum('bhqd,bhkd->bhqk', qc, kc) * decay, vc)
        cross = jnp.einsum('bhqd,bhde->bhqe', qc, state) * q_dec[:, :, None]
        state = state * c_dec[:, None, None] + jnp.einsum('bhkd,bhke->bhde', kc * k_dec[:, :, None], vc)
        return state, inner + cross

    state0 = jnp.zeros((B, H, dk, dv), f32)
    _, o = lax.scan(step, state0, (chunks(q), chunks(k), chunks(v)))
    o = o.transpose(1, 0, 3, 2, 4).reshape(B, S, H, dv)
    mu = jnp.mean(o, axis=-1, keepdims=True)
    var = jnp.mean(jnp.square(o - mu), axis=-1, keepdims=True)
    o = ((o - mu) * lax.rsqrt(var + LN_EPS)).reshape(B, S, H * dv)
    return (jax.nn.silu(g.astype(f32)) * o).astype(h.dtype) @ w_o


def nsa_shared_kv(xs, w_kv, cmp_pe, cmp_w1, cmp_b1, cmp_w2):
    B, S, _ = xs.shape
    G, hd = NSA_GROUPS, NSA_HEAD_DIM
    kv = (xs @ w_kv).reshape(B, S, N_BRANCH, 2, G, hd).transpose(2, 3, 0, 4, 1, 5)
    pieces = kv[0].reshape(2, B, G, S // CMP_STRIDE, CMP_STRIDE, hd)
    blocks = jnp.concatenate([pieces[:, :, :, :-1], pieces[:, :, :, 1:]], axis=4)
    blocks = blocks + cmp_pe[:, None, None, None]
    n_cmp = blocks.shape[3]
    flat = blocks.reshape(2, B, G, n_cmp, CMP_LEN * hd)
    hid = jax.nn.gelu(jnp.einsum('cbgnf,cfh->cbgnh', flat, cmp_w1) + cmp_b1[:, None, None, None])
    comp = jnp.einsum('cbgnh,chd->cbgnd', hid, cmp_w2)
    slc = kv[1].reshape(2, B, G, S // SLC_BLOCK, SLC_BLOCK, hd)
    win = jnp.pad(kv[2], ((0, 0), (0, 0), (0, 0), (WINDOW, 0), (0, 0)))
    return comp[0], comp[1], slc[0], slc[1], win[0], win[1]


def cmp_to_slc_matrix(n_cmp, n_slc):
    i = np.arange(n_cmp)[:, None] * CMP_STRIDE
    j = np.arange(n_slc)[None, :] * SLC_BLOCK
    ov = np.minimum(i + CMP_LEN, j + SLC_BLOCK) - np.maximum(i, j)
    return jnp.asarray(np.clip(ov, 0, None) / CMP_LEN, dtype=jnp.float32)


def nsa(h, w_in, w_o, k_cmp, v_cmp, k_slc, v_slc, k_win, v_win):
    B, S, _ = h.shape
    G, R, hd, QB = NSA_GROUPS, NSA_REP, NSA_HEAD_DIM, Q_BLOCK
    f32 = jnp.float32
    n_cmp = k_cmp.shape[2]
    n_slc = k_slc.shape[2]
    n_sel = min(SLC_TOPK, n_slc)
    proj = h @ w_in
    q = proj[..., :NSA_HEADS * hd].reshape(B, S, G, R, hd) * (hd ** -0.5)
    gate = jax.nn.sigmoid(proj[..., NSA_HEADS * hd:].astype(f32)).reshape(B, S, G, R, N_BRANCH)
    nqb = S // QB
    q_blocks = q.reshape(B, nqb, QB, G, R, hd).transpose(1, 0, 3, 4, 2, 5)
    g_blocks = gate.reshape(B, nqb, QB, G, R, N_BRANCH).transpose(1, 0, 3, 4, 2, 5)
    starts = jnp.arange(nqb, dtype=jnp.int32) * QB
    c2s = cmp_to_slc_matrix(n_cmp, n_slc)
    cmp_end = jnp.arange(n_cmp) * CMP_STRIDE + CMP_LEN - 1
    slc_idx = jnp.arange(n_slc)
    slc_start = slc_idx * SLC_BLOCK
    bi = jnp.arange(B)[:, None, None, None]
    gi = jnp.arange(G)[None, :, None, None]

    def block(args):
        qb, gb, start = args
        t = start + jnp.arange(QB)
        s = jnp.einsum('bgrqd,bgnd->bgrqn', qb, k_cmp, preferred_element_type=f32)
        p_cmp = masked_softmax(s, cmp_end[None, :] <= t[:, None])
        o_cmp = jnp.einsum('bgrqn,bgnd->bgrqd', p_cmp.astype(v_cmp.dtype), v_cmp)
        imp = jnp.einsum('bgqn,nj->bgqj', p_cmp.sum(axis=2), c2s)
        cur = t // SLC_BLOCK
        forced = (slc_idx[None] == 0) | (slc_idx[None] == cur[:, None]) | (slc_idx[None] == cur[:, None] - 1)
        avail = slc_start[None] <= t[:, None]
        score = jnp.where(avail, imp + jnp.where(forced, FORCE_BONUS, 0.0), -1.0)
        top_s, top_i = lax.top_k(score, n_sel)
        ks = k_slc[bi, gi, top_i]
        vs = v_slc[bi, gi, top_i]
        tok = top_i[..., None] * SLC_BLOCK + jnp.arange(SLC_BLOCK)
        smask = (tok <= t[:, None, None]) & (top_s >= 0.0)[..., None]
        s = jnp.einsum('bgrqd,bgqnkd->bgrqnk', qb, ks, preferred_element_type=f32)
        p = masked_softmax(s.reshape(B, G, R, QB, n_sel * SLC_BLOCK),
                           smask.reshape(B, G, 1, QB, n_sel * SLC_BLOCK))
        o_slc = jnp.einsum('bgrqm,bgqmd->bgrqd', p.astype(v_slc.dtype),
                           vs.reshape(B, G, QB, n_sel * SLC_BLOCK, hd))
        kw = lax.dynamic_slice_in_dim(k_win, start, WINDOW + QB, axis=2)
        vw = lax.dynamic_slice_in_dim(v_win, start, WINDOW + QB, axis=2)
        kp = start - WINDOW + jnp.arange(WINDOW + QB)
        wmask = (kp[None] <= t[:, None]) & (kp[None] > t[:, None] - WINDOW) & (kp[None] >= 0)
        s = jnp.einsum('bgrqd,bgkd->bgrqk', qb, kw, preferred_element_type=f32)
        o_win = jnp.einsum('bgrqk,bgkd->bgrqd', masked_softmax(s, wmask).astype(vw.dtype), vw)
        out = gb[..., 0:1] * o_cmp + gb[..., 1:2] * o_slc + gb[..., 2:3] * o_win
        return out.astype(qb.dtype)

    o = lax.map(block, (q_blocks, g_blocks, starts))
    o = o.transpose(1, 0, 4, 2, 3, 5).reshape(B, S, NSA_HEADS * hd)
    return o @ w_o


def peer(h, w_q, sub_keys, u_tab, v_tab):
    B, S, D = h.shape
    f32 = jnp.float32
    xt = h.reshape(-1, PEER_TOKENS, D)

    def chunk_fn(xc):
        T = xc.shape[0]
        q = (xc @ w_q).reshape(T, PEER_HEADS, 2, PEER_QDIM // 2)
        s = jnp.einsum('thcd,hcnd->thcn', q, sub_keys, preferred_element_type=f32)
        sv, si = lax.top_k(s, PEER_TOPK)
        comb = (sv[:, :, 0, :, None] + sv[:, :, 1, None, :]).reshape(T, PEER_HEADS, PEER_TOPK * PEER_TOPK)
        cv, ci = lax.top_k(comb, PEER_TOPK)
        i1 = jnp.take_along_axis(si[:, :, 0], ci // PEER_TOPK, axis=-1)
        i2 = jnp.take_along_axis(si[:, :, 1], ci % PEER_TOPK, axis=-1)
        eidx = i1 * PEER_NKEYS + i2
        w = jax.nn.softmax(cv, axis=-1)
        u = u_tab[eidx]
        a = jax.nn.gelu(jnp.einsum('td,thkd->thk', xc, u, preferred_element_type=f32)) * w
        return jnp.einsum('thk,thkd->td', a.astype(v_tab.dtype), v_tab[eidx])

    return lax.map(chunk_fn, xt).reshape(B, S, D)


def setup_inputs(seed: int = 0) -> dict:
    key = jax.random.key(seed)
    ks = jax.random.split(key, 24)
    D = D_MODEL
    nrm = lambda k, shape, std: jax.random.normal(k, shape, jnp.float32) * std
    return {
        "x": nrm(ks[0], (BATCH, SEQ, D), 1.0),
        "c": nrm(ks[1], (BATCH, D), 1.0),
        "ada_w": nrm(ks[2], (DEPTH, D, 6 * D), 0.5 * D ** -0.5),
        "ada_b": nrm(ks[3], (DEPTH, 6 * D), 0.02),
        "ln_g": 1.0 + nrm(ks[4], (DEPTH, 2, D), 0.02),
        "ln_b": nrm(ks[5], (DEPTH, 2, D), 0.02),
        "ret_w_in": nrm(ks[6], (N_A_LAYERS, D, RET_IN), D ** -0.5),
        "ret_w_o": nrm(ks[7], (N_A_LAYERS, RET_HEADS * RET_V_DIM, D), BETA * (RET_HEADS * RET_V_DIM) ** -0.5),
        "kv_ada_w": nrm(ks[8], (D, 2 * D), 0.5 * D ** -0.5),
        "kv_ada_b": nrm(ks[9], (2 * D,), 0.02),
        "nsa_w_kv": nrm(ks[10], (D, NSA_KV), D ** -0.5),
        "cmp_pe": nrm(ks[11], (2, CMP_LEN, NSA_HEAD_DIM), 0.1),
        "cmp_w1": nrm(ks[12], (2, CMP_LEN * NSA_HEAD_DIM, CMP_HIDDEN), (CMP_LEN * NSA_HEAD_DIM) ** -0.5),
        "cmp_b1": nrm(ks[13], (2, CMP_HIDDEN), 0.02),
        "cmp_w2": nrm(ks[14], (2, CMP_HIDDEN, NSA_HEAD_DIM), CMP_HIDDEN ** -0.5),
        "nsa_w_in": nrm(ks[15], (N_B_LAYERS, D, NSA_IN), D ** -0.5),
        "nsa_w_o": nrm(ks[16], (N_B_LAYERS, NSA_HEADS * NSA_HEAD_DIM, D), BETA * (NSA_HEADS * NSA_HEAD_DIM) ** -0.5),
        "peer_w_q": nrm(ks[17], (DEPTH, D, PEER_HEADS * PEER_QDIM), D ** -0.5),
        "peer_keys": nrm(ks[18], (DEPTH, PEER_HEADS, 2, PEER_NKEYS, PEER_QDIM // 2), (PEER_QDIM // 2) ** -0.5),
        "peer_u": nrm(ks[19], (DEPTH, PEER_EXPERTS, D), D ** -0.5),
        "peer_v": nrm(ks[20], (DEPTH, PEER_EXPERTS, D), BETA),
    }


def reference(x, c, ada_w, ada_b, ln_g, ln_b, ret_w_in, ret_w_o, kv_ada_w, kv_ada_b, nsa_w_kv,
              cmp_pe, cmp_w1, cmp_b1, cmp_w2, nsa_w_in, nsa_w_o, peer_w_q, peer_keys, peer_u, peer_v):
    c_act = jax.nn.silu(c)
    shared = None
    for layer in range(DEPTH):
        mod = (c_act @ ada_w[layer] + ada_b[layer])[:, None, :]
        sh1, sc1, g1, sh2, sc2, g2 = jnp.split(mod, 6, axis=-1)
        h = x * (1.0 + sc1) + sh1
        if layer < N_A_LAYERS:
            y = retention(h, ret_w_in[layer], ret_w_o[layer])
        else:
            lb = layer - N_A_LAYERS
            y = nsa(h, nsa_w_in[lb], nsa_w_o[lb], *shared)
        x = layer_norm(ALPHA * x + g1 * y, ln_g[layer, 0], ln_b[layer, 0])
        h = x * (1.0 + sc2) + sh2
        y = peer(h, peer_w_q[layer], peer_keys[layer], peer_u[layer], peer_v[layer])
        x = layer_norm(ALPHA * x + g2 * y, ln_g[layer, 1], ln_b[layer, 1])
        if layer == N_A_LAYERS - 1:
            kv_mod = (c_act @ kv_ada_w + kv_ada_b)[:, None, :]
            kv_sh, kv_sc = jnp.split(kv_mod, 2, axis=-1)
            shared = nsa_shared_kv(x * (1.0 + kv_sc) + kv_sh, nsa_w_kv, cmp_pe, cmp_w1, cmp_b1, cmp_w2)
    return x
```

```cpp
#include <hip/hip_runtime.h>
#include <hip/hip_cooperative_groups.h>
#include <cstdio>
#include <cstdint>
namespace cg = cooperative_groups;

typedef unsigned short bf16_t;
typedef short bf16x8 __attribute__((ext_vector_type(8)));
typedef float f32x16 __attribute__((ext_vector_type(16)));
typedef float f32x2 __attribute__((ext_vector_type(2)));

#ifndef PROBE_ID
#define PROBE_ID 0
#endif
#ifndef MULTI_LAUNCH
#define MULTI_LAUNCH 0
#endif

#define T_ 16384
#define S_ 8192
#define D_ 1024
#define ALPHA_ 1.681792830507429f
#define LN_EPS_ 1e-5f
#define SMEM_BYTES 73728
#define LSTR 72

struct P {
  const float *x, *c, *ada_w, *ada_b, *ln_g, *ln_b, *ret_w_in, *ret_w_o, *kv_ada_w, *kv_ada_b, *nsa_w_kv,
      *cmp_pe, *cmp_w1, *cmp_b1, *cmp_w2, *nsa_w_in, *nsa_w_o, *peer_w_q, *peer_keys, *peer_u, *peer_v;
  float* out;
  bf16_t *retWinT, *retWoT, *kvWT, *w1T, *w2T, *nsaWinT, *nsaWoT, *wqT, *keysB;
  unsigned char *uB, *vB;
  float *su, *sv;
  float *mods, *kvmod, *cs, *biasp;
  float* xbuf;
  bf16_t *hbuf, *xsbuf;
  bf16_t *kvbuf, *hid, *Kc, *VcT;
  bf16_t *Qd, *Kd, *KdT, *VT, *Gs, *ST, *Pb, *Ob;
  bf16_t* qp;
  int* topk;
  bf16_t* Qn;
  float* gate;
  bf16_t* Oattn;
  unsigned* bar;
};

__device__ __forceinline__ int otid() {
  int t = threadIdx.x;
  asm volatile("" : "+v"(t));
  return t;
}
__device__ __forceinline__ float bf2f(bf16_t b) { return __uint_as_float(((unsigned)b) << 16); }
__device__ __forceinline__ bf16_t f2bf(float f) {
  unsigned u = __float_as_uint(f);
  u += 0x7fffu + ((u >> 16) & 1u);
  return (bf16_t)(u >> 16);
}
typedef __bf16 bf16x2_t __attribute__((ext_vector_type(2)));
__device__ __forceinline__ unsigned pack2(float a, float b) {
  f32x2 v = {a, b};
  bf16x2_t r = __builtin_convertvector(v, bf16x2_t);
  return __builtin_bit_cast(unsigned, r);
}
__device__ __forceinline__ float ex2(float x) { return __builtin_amdgcn_exp2f(x); }
__device__ __forceinline__ float gelu_t(float x) {
  float u = 0.7978845608028654f * (x + 0.044715f * x * x * x);
  return x / (1.f + __expf(-2.f * u));
}
__device__ __forceinline__ float silu_f(float x) { return x / (1.f + __expf(-x)); }
__device__ __forceinline__ float sigmoid_f(float x) { return 1.f / (1.f + __expf(-x)); }
__device__ __forceinline__ float wave_allsum(float v) {
#pragma unroll
  for (int o = 32; o >= 1; o >>= 1) v += __shfl_xor(v, o);
  return v;
}
__device__ __forceinline__ f32x16 mfma32(bf16x8 a, bf16x8 b, f32x16 c) {
  return __builtin_amdgcn_mfma_f32_32x32x16_bf16(a, b, c, 0, 0, 0);
}

__device__ __forceinline__ void gemm_tile(const bf16_t* __restrict__ A, long lda, const bf16_t* __restrict__ B, long ldb,
                                          int K, f32x16 (&acc)[2][2], unsigned char* smem) {
  const int tid = otid(), lane = tid & 63, wave = tid >> 6;
  const int wm = wave >> 1, wn = wave & 1;
  const int lr = tid >> 3, lc = (tid & 7) * 8;
  bf16_t* sA = (bf16_t*)smem;
  bf16_t* sB = sA + 2 * 128 * LSTR;
  const bf16_t* Ap = A + (long)lr * lda + lc;
  const bf16_t* Bp = B + (long)lr * ldb + lc;
  uint4 ra0_0, ra0_1, ra0_2, ra0_3, rb0_0, rb0_1, rb0_2, rb0_3, ra1_0, ra1_1, ra1_2, ra1_3, rb1_0, rb1_1, rb1_2, rb1_3;
  const int nk = K >> 6;
#define G_LOAD1(RA, RB, KT, i)                                        \
  RA##_##i = *(const uint4*)(Ap + (long)(i * 32) * lda + (KT) * 64);       \
  RB##_##i = *(const uint4*)(Bp + (long)(i * 32) * ldb + (KT) * 64);
#define G_LOAD(RA, RB, KT) G_LOAD1(RA, RB, KT, 0) G_LOAD1(RA, RB, KT, 1) G_LOAD1(RA, RB, KT, 2) G_LOAD1(RA, RB, KT, 3)
#define G_STORE1(RA, RB, BUF, i)                                                  \
  *(uint4*)(sA + (BUF) * 128 * LSTR + (lr + i * 32) * LSTR + lc) = RA##_##i;         \
  *(uint4*)(sB + (BUF) * 128 * LSTR + (lr + i * 32) * LSTR + lc) = RB##_##i;
#define G_STORE(RA, RB, BUF) G_STORE1(RA, RB, BUF, 0) G_STORE1(RA, RB, BUF, 1) G_STORE1(RA, RB, BUF, 2) G_STORE1(RA, RB, BUF, 3)
#define G_CK(BUF, kk)                                                                                       \
  {                                                                                                         \
    bf16x8 a0 = *(const bf16x8*)(a_s + (BUF) * 128 * LSTR + kk * 16);                                       \
    bf16x8 a1 = *(const bf16x8*)(a_s + (BUF) * 128 * LSTR + 32 * LSTR + kk * 16);                           \
    bf16x8 b0 = *(const bf16x8*)(b_s + (BUF) * 128 * LSTR + kk * 16);                                       \
    bf16x8 b1 = *(const bf16x8*)(b_s + (BUF) * 128 * LSTR + 64 * LSTR + kk * 16);                           \
    acc[0][0] = mfma32(a0, b0, acc[0][0]);                                                                  \
    acc[0][1] = mfma32(a0, b1, acc[0][1]);                                                                  \
    acc[1][0] = mfma32(a1, b0, acc[1][0]);                                                                  \
    acc[1][1] = mfma32(a1, b1, acc[1][1]);                                                                  \
  }
#define G_COMPUTE(BUF) G_CK(BUF, 0) G_CK(BUF, 1) G_CK(BUF, 2) G_CK(BUF, 3)
  const bf16_t* a_s = sA + (wm * 64 + (lane & 31)) * LSTR + (lane >> 5) * 8;
  const bf16_t* b_s = sB + (wn * 32 + (lane & 31)) * LSTR + (lane >> 5) * 8;
  __syncthreads();
  G_LOAD(ra0, rb0, 0);
  G_LOAD(ra1, rb1, 1);
  G_STORE(ra0, rb0, 0);
  __syncthreads();
#pragma unroll 1
  for (int kt = 0; kt < nk; kt += 2) {
    if (kt + 2 < nk) { G_LOAD(ra0, rb0, kt + 2); }
    G_COMPUTE(0);
    G_STORE(ra1, rb1, 1);
    __syncthreads();
    if (kt + 3 < nk) { G_LOAD(ra1, rb1, kt + 3); }
    G_COMPUTE(1);
    if (kt + 2 < nk) { G_STORE(ra0, rb0, 0); }
    __syncthreads();
  }
#undef G_LOAD
#undef G_LOAD1
#undef G_STORE
#undef G_STORE1
#undef G_COMPUTE
#undef G_CK
}

__device__ __forceinline__ void gemm_tile_w41(const bf16_t* __restrict__ A, long lda, const bf16_t* __restrict__ B, long ldb,
                                              int K, f32x16 (&acc)[4], unsigned char* smem) {
  const int tid = otid(), lane = tid & 63, wave = tid >> 6;
  const int lr = tid >> 3, lc = (tid & 7) * 8;
  bf16_t* sA = (bf16_t*)smem;
  bf16_t* sB = sA + 2 * 128 * LSTR;
  const bf16_t* Ap = A + (long)lr * lda + lc;
  const bf16_t* Bp = B + (long)lr * ldb + lc;
  uint4 ra0_0, ra0_1, ra0_2, ra0_3, rb0_0, rb0_1, rb0_2, rb0_3, ra1_0, ra1_1, ra1_2, ra1_3, rb1_0, rb1_1, rb1_2, rb1_3;
  const int nk = K >> 6;
#define G_LOAD1(RA, RB, KT, i)                                        \
  RA##_##i = *(const uint4*)(Ap + (long)(i * 32) * lda + (KT) * 64);  \
  RB##_##i = *(const uint4*)(Bp + (long)(i * 32) * ldb + (KT) * 64);
#define G_LOAD(RA, RB, KT) G_LOAD1(RA, RB, KT, 0) G_LOAD1(RA, RB, KT, 1) G_LOAD1(RA, RB, KT, 2) G_LOAD1(RA, RB, KT, 3)
#define G_STORE1(RA, RB, BUF, i)                                                  \
  *(uint4*)(sA + (BUF) * 128 * LSTR + (lr + i * 32) * LSTR + lc) = RA##_##i;      \
  *(uint4*)(sB + (BUF) * 128 * LSTR + (lr + i * 32) * LSTR + lc) = RB##_##i;
#define G_STORE(RA, RB, BUF) G_STORE1(RA, RB, BUF, 0) G_STORE1(RA, RB, BUF, 1) G_STORE1(RA, RB, BUF, 2) G_STORE1(RA, RB, BUF, 3)
#define G_CK(BUF, kk)                                                                         \
  {                                                                                           \
    bf16x8 b0 = *(const bf16x8*)(b_s + (BUF) * 128 * LSTR + kk * 16);                         \
    bf16x8 a0 = *(const bf16x8*)(a_s + (BUF) * 128 * LSTR + kk * 16);                         \
    bf16x8 a1 = *(const bf16x8*)(a_s + (BUF) * 128 * LSTR + 32 * LSTR + kk * 16);             \
    bf16x8 a2 = *(const bf16x8*)(a_s + (BUF) * 128 * LSTR + 64 * LSTR + kk * 16);             \
    bf16x8 a3 = *(const bf16x8*)(a_s + (BUF) * 128 * LSTR + 96 * LSTR + kk * 16);             \
    acc[0] = mfma32(a0, b0, acc[0]);                                                          \
    acc[1] = mfma32(a1, b0, acc[1]);                                                          \
    acc[2] = mfma32(a2, b0, acc[2]);                                                          \
    acc[3] = mfma32(a3, b0, acc[3]);                                                          \
  }
#define G_COMPUTE(BUF) G_CK(BUF, 0) G_CK(BUF, 1) G_CK(BUF, 2) G_CK(BUF, 3)
  const bf16_t* a_s = sA + (lane & 31) * LSTR + (lane >> 5) * 8;
  const bf16_t* b_s = sB + (wave * 32 + (lane & 31)) * LSTR + (lane >> 5) * 8;
  __syncthreads();
  G_LOAD(ra0, rb0, 0);
  G_LOAD(ra1, rb1, 1);
  G_STORE(ra0, rb0, 0);
  __syncthreads();
#pragma unroll 1
  for (int kt = 0; kt < nk; kt += 2) {
    if (kt + 2 < nk) { G_LOAD(ra0, rb0, kt + 2); }
    G_COMPUTE(0);
    G_STORE(ra1, rb1, 1);
    __syncthreads();
    if (kt + 3 < nk) { G_LOAD(ra1, rb1, kt + 3); }
    G_COMPUTE(1);
    if (kt + 2 < nk) { G_STORE(ra0, rb0, 0); }
    __syncthreads();
  }
#undef G_LOAD
#undef G_LOAD1
#undef G_STORE
#undef G_STORE1
#undef G_COMPUTE
#undef G_CK
}

__device__ __forceinline__ void gemm_tile256(const bf16_t* __restrict__ A, long lda, const bf16_t* __restrict__ B, long ldb,
                                             int K, f32x16 (&acc)[2][4], unsigned char* smem) {
  const int tid = otid(), lane = tid & 63, wave = tid >> 6;
  const int lr = tid >> 3, lc = (tid & 7) * 8;
  bf16_t* sA = (bf16_t*)smem;
  bf16_t* sB = sA + 256 * LSTR;
  const bf16_t* Ap = A + (long)lr * lda + lc;
  const bf16_t* Bp = B + (long)lr * ldb + lc;
  uint4 a_0, a_1, a_2, a_3, a_4, a_5, a_6, a_7, b_0, b_1, b_2, b_3;
  const int nk = K >> 6;
#define H_LA(i, KT) a_##i = *(const uint4*)(Ap + (long)(i * 32) * lda + (KT) * 64);
#define H_LB(i, KT) b_##i = *(const uint4*)(Bp + (long)(i * 32) * ldb + (KT) * 64);
#define H_LOAD(KT) H_LA(0, KT) H_LA(1, KT) H_LA(2, KT) H_LA(3, KT) H_LA(4, KT) H_LA(5, KT) H_LA(6, KT) H_LA(7, KT) H_LB(0, KT) H_LB(1, KT) H_LB(2, KT) H_LB(3, KT)
#define H_SA(i) *(uint4*)(sA + (lr + i * 32) * LSTR + lc) = a_##i;
#define H_SB(i) *(uint4*)(sB + (lr + i * 32) * LSTR + lc) = b_##i;
#define H_STORE() H_SA(0) H_SA(1) H_SA(2) H_SA(3) H_SA(4) H_SA(5) H_SA(6) H_SA(7) H_SB(0) H_SB(1) H_SB(2) H_SB(3)
  const bf16_t* a_s = sA + (wave * 64 + (lane & 31)) * LSTR + (lane >> 5) * 8;
  const bf16_t* b_s = sB + (lane & 31) * LSTR + (lane >> 5) * 8;
  H_LOAD(0);
#pragma unroll 1
  for (int kt = 0; kt < nk; kt++) {
    __syncthreads();
    H_STORE();
    __syncthreads();
    const int kn = (kt + 1 < nk) ? kt + 1 : kt;
    H_LOAD(kn);
    __builtin_amdgcn_sched_barrier(0);
#pragma unroll
    for (int kk = 0; kk < 4; kk++) {
      bf16x8 fa0 = *(const bf16x8*)(a_s + kk * 16);
      bf16x8 fa1 = *(const bf16x8*)(a_s + 32 * LSTR + kk * 16);
      bf16x8 fb0 = *(const bf16x8*)(b_s + kk * 16);
      bf16x8 fb1 = *(const bf16x8*)(b_s + 32 * LSTR + kk * 16);
      bf16x8 fb2 = *(const bf16x8*)(b_s + 64 * LSTR + kk * 16);
      bf16x8 fb3 = *(const bf16x8*)(b_s + 96 * LSTR + kk * 16);
      acc[0][0] = mfma32(fa0, fb0, acc[0][0]);
      acc[0][1] = mfma32(fa0, fb1, acc[0][1]);
      acc[0][2] = mfma32(fa0, fb2, acc[0][2]);
      acc[0][3] = mfma32(fa0, fb3, acc[0][3]);
      acc[1][0] = mfma32(fa1, fb0, acc[1][0]);
      acc[1][1] = mfma32(fa1, fb1, acc[1][1]);
      acc[1][2] = mfma32(fa1, fb2, acc[1][2]);
      acc[1][3] = mfma32(fa1, fb3, acc[1][3]);
    }
  }
  __syncthreads();
#undef H_LA
#undef H_LB
#undef H_LOAD
#undef H_SA
#undef H_SB
#undef H_STORE
}
template <class F>
__device__ __forceinline__ void epi_pairs256(const f32x16 (&acc)[2][4], F f) {
  const int tid_ = otid();
  const int lane = tid_ & 63, wave = tid_ >> 6;
#pragma unroll
  for (int mi = 0; mi < 2; mi++)
#pragma unroll
    for (int np = 0; np < 2; np++)
#pragma unroll
      for (int rq = 0; rq < 4; rq++) {
        int row0 = wave * 64 + mi * 32 + rq * 8 + (lane >> 5) * 4;
        int col0 = np * 32 + (lane & 31);
        float v0[4], v1[4];
#pragma unroll
        for (int j = 0; j < 4; j++) {
          v0[j] = acc[mi][np][rq * 4 + j];
          v1[j] = acc[mi][np + 2][rq * 4 + j];
        }
        f(row0, col0, v0, v1);
      }
}

__device__ __forceinline__ void tile_map(int it, int ntm, int ntn, int mode, int& tm, int& tn) {
  const int G = gridDim.x, total = ntm * ntn;
  const int r = it / G, b = it - r * G;
  int t2 = it;
  if (mode == 1 && (G & 63) == 0 && (r + 1) * G > total) {
    const int rem = total - r * G;
    if ((rem & 7) == 0 && b < rem) t2 = r * G + (b & 7) * (rem >> 3) + (b >> 3);
  }
  if ((G & 63) == 0 && (r + 1) * G <= total) {
    const int xcd = b & 7, j = b >> 3, cpx = G >> 3;
    if (mode == 1) {
      t2 = r * G + xcd * cpx + j;
    } else if (mode == 2 && cpx == 64 && (ntn & 7) == 0 && (ntm & 7) == 0) {
      const int q = r * 8 + xcd, npn = ntn >> 3;
      const int qm = q / npn, qn = q - qm * npn;
      tm = qm * 8 + (j >> 3);
      tn = qn * 8 + (j & 7);
      return;
    }
  }
  tn = t2 % ntn;
  tm = t2 / ntn;
}

__device__ __forceinline__ int item_swz(int it, int total) {
  const int G = gridDim.x;
  const int r = it / G, b = it - r * G;
  if ((G & 7) == 0) {
    if ((r + 1) * G <= total) return r * G + (b & 7) * (G >> 3) + (b >> 3);
    const int rem = total - r * G;
    if ((rem & 7) == 0 && b < rem) return r * G + (b & 7) * (rem >> 3) + (b >> 3);
  }
  return it;
}
__device__ __forceinline__ void zero_acc(f32x16 (&acc)[2][2]) {
#pragma unroll
  for (int i = 0; i < 2; i++)
#pragma unroll
    for (int j = 0; j < 2; j++)
#pragma unroll
      for (int r = 0; r < 16; r++) acc[i][j][r] = 0.f;
}

template <class F>
__device__ __forceinline__ void epi_pairs(const f32x16 (&acc)[2][2], F f) {
  const int tid_ = otid(); const int lane = tid_ & 63, wave = tid_ >> 6, wm = wave >> 1, wn = wave & 1;
#pragma unroll
  for (int mi = 0; mi < 2; mi++)
#pragma unroll
    for (int rq = 0; rq < 4; rq++) {
      int row0 = wm * 64 + mi * 32 + rq * 8 + (lane >> 5) * 4;
      int col0 = wn * 32 + (lane & 31);
      float v0[4], v1[4];
#pragma unroll
      for (int j = 0; j < 4; j++) {
        v0[j] = acc[mi][0][rq * 4 + j];
        v1[j] = acc[mi][1][rq * 4 + j];
      }
      f(row0, col0, v0, v1);
    }
}

__device__ __forceinline__ void transpose_job(const float* __restrict__ src, int K, int N, bf16_t* __restrict__ dst, int Npad, int perm,
                              unsigned char* smem) {
  float* t = (float*)smem;
  const int tid = otid();
  const int tilesN = Npad / 64, tilesK = K / 64;
  for (int it = blockIdx.x; it < tilesN * tilesK; it += gridDim.x) {
    int tn = it % tilesN, tk = it / tilesN;
    int n0 = tn * 64, k0 = tk * 64;
    int sn0 = n0;
    if (perm && n0 < 2048) {
      int hd = n0 >> 8, t2 = (n0 >> 7) & 1, half = (n0 >> 6) & 1;
      sn0 = hd * 256 + half * 128 + t2 * 64;
    }
    __syncthreads();
    {
      int kk = tid >> 2;
#pragma unroll
      for (int j = 0; j < 4; j++) {
        int cc = (tid & 3) * 16 + j * 4;
        float4 v = make_float4(0.f, 0.f, 0.f, 0.f);
        if (sn0 + cc < N) v = *(const float4*)(src + (long)(k0 + kk) * N + sn0 + cc);
        t[(cc + 0) * 65 + kk] = v.x;
        t[(cc + 1) * 65 + kk] = v.y;
        t[(cc + 2) * 65 + kk] = v.z;
        t[(cc + 3) * 65 + kk] = v.w;
      }
    }
    __syncthreads();
    {
      int n = tid >> 2, kc = (tid & 3) * 16;
      unsigned w[8];
#pragma unroll
      for (int j = 0; j < 8; j++) w[j] = pack2(t[n * 65 + kc + 2 * j], t[n * 65 + kc + 2 * j + 1]);
      uint4* d = (uint4*)(dst + (long)(n0 + n) * K + k0 + kc);
      d[0] = make_uint4(w[0], w[1], w[2], w[3]);
      d[1] = make_uint4(w[4], w[5], w[6], w[7]);
    }
  }
}

__device__ __forceinline__ void convert_job(const float* __restrict__ src, bf16_t* __restrict__ dst, long n) {
  long i = ((long)blockIdx.x * 256 + otid()) * 8;
  long stride = (long)gridDim.x * 256 * 8;
  for (; i < n; i += stride) {
    float4 a = *(const float4*)(src + i), b = *(const float4*)(src + i + 4);
    *(uint4*)(dst + i) = make_uint4(pack2(a.x, a.y), pack2(a.z, a.w), pack2(b.x, b.y), pack2(b.z, b.w));
  }
}


__device__ __forceinline__ float dpp_rowsum(float v) {
  v += __int_as_float(__builtin_amdgcn_update_dpp(0, __float_as_int(v), 0xB1, 0xF, 0xF, true));
  v += __int_as_float(__builtin_amdgcn_update_dpp(0, __float_as_int(v), 0x4E, 0xF, 0xF, true));
  v += __int_as_float(__builtin_amdgcn_update_dpp(0, __float_as_int(v), 0x141, 0xF, 0xF, true));
  v += __int_as_float(__builtin_amdgcn_update_dpp(0, __float_as_int(v), 0x140, 0xF, 0xF, true));
  return v;
}
__device__ __forceinline__ float wave_allsum_fast(float v) {
  v = dpp_rowsum(v);
  float s0 = __int_as_float(__builtin_amdgcn_readlane(__float_as_int(v), 0));
  float s1 = __int_as_float(__builtin_amdgcn_readlane(__float_as_int(v), 16));
  float s2 = __int_as_float(__builtin_amdgcn_readlane(__float_as_int(v), 32));
  float s3 = __int_as_float(__builtin_amdgcn_readlane(__float_as_int(v), 48));
  return (s0 + s1) + (s2 + s3);
}
__device__ __forceinline__ void convert_fp8_job(const float* __restrict__ src, unsigned char* __restrict__ dst, float* __restrict__ inv_scale, int rows) {
  const int tid = otid(), lane = tid & 63, wave = tid >> 6;
  for (int r = blockIdx.x * 4 + wave; r < rows; r += gridDim.x * 4) {
    const float* sr = src + (long)r * 1024;
    float v[16];
#pragma unroll
    for (int j = 0; j < 2; j++) {
      float4 a = *(const float4*)(sr + j * 512 + lane * 8), b = *(const float4*)(sr + j * 512 + lane * 8 + 4);
      v[j * 8 + 0] = a.x; v[j * 8 + 1] = a.y; v[j * 8 + 2] = a.z; v[j * 8 + 3] = a.w;
      v[j * 8 + 4] = b.x; v[j * 8 + 5] = b.y; v[j * 8 + 6] = b.z; v[j * 8 + 7] = b.w;
    }
    float mx = 0.f;
#pragma unroll
    for (int i = 0; i < 16; i++) mx = fmaxf(mx, fabsf(v[i]));
#pragma unroll
    for (int o = 32; o >= 1; o >>= 1) mx = fmaxf(mx, __shfl_xor(mx, o));
    mx = fmaxf(mx, 1e-20f);
    float sc = 384.f / mx;
    int w[4];
#pragma unroll
    for (int q = 0; q < 4; q++) {
      int x = 0;
      x = __builtin_amdgcn_cvt_pk_fp8_f32(v[q * 4 + 0] * sc, v[q * 4 + 1] * sc, x, false);
      x = __builtin_amdgcn_cvt_pk_fp8_f32(v[q * 4 + 2] * sc, v[q * 4 + 3] * sc, x, true);
      w[q] = x;
    }
    *(int4*)(dst + (long)r * 2048 + lane * 16) = make_int4(w[0], w[1], w[2], w[3]);
    if (lane == 0) inv_scale[r] = mx * (1.f / 384.f);
  }
}

__device__ __forceinline__ void modvec_job(const float* __restrict__ c, const float* __restrict__ W, const float* __restrict__ bias,
                           float* __restrict__ out, int N, int item0, int nitems_total_before, unsigned char* smem) {
}

__device__ __forceinline__ void prep_phase(const P& p, unsigned char* smem) {
  for (int l = 0; l < 2; l++) {
    transpose_job(p.ret_w_in + (long)l * 1024 * 6144, 1024, 6144, p.retWinT + (long)l * 6144 * 1024, 6144, 1, smem);
    transpose_job(p.ret_w_o + (long)l * 2048 * 1024, 2048, 1024, p.retWoT + (long)l * 1024 * 2048, 1024, 0, smem);
    transpose_job(p.cmp_w1 + (long)l * 2048 * 256, 2048, 256, p.w1T + (long)l * 256 * 2048, 256, 0, smem);
    transpose_job(p.cmp_w2 + (long)l * 256 * 64, 256, 64, p.w2T + (long)l * 128 * 256, 128, 0, smem);
    transpose_job(p.nsa_w_in + (long)l * 1024 * 1072, 1024, 1072, p.nsaWinT + (long)l * 1152 * 1024, 1152, 0, smem);
    transpose_job(p.nsa_w_o + (long)l * 1024 * 1024, 1024, 1024, p.nsaWoT + (long)l * 1024 * 1024, 1024, 0, smem);
  }
  transpose_job(p.nsa_w_kv, 1024, 1536, p.kvWT, 1536, 0, smem);
  for (int l = 0; l < 4; l++)
    transpose_job(p.peer_w_q + (long)l * 1024 * 2048, 1024, 2048, p.wqT + (long)l * 2048 * 1024, 2048, 0, smem);
  convert_job(p.peer_keys, p.keysB, 4L * 8 * 2 * 128 * 128);
  convert_fp8_job(p.peer_u, p.uB, p.su, 4 * 16384);
  convert_fp8_job(p.peer_v, p.uB + 1024, p.sv, 4 * 16384);
  {
    __syncthreads();
    float* red = (float*)smem;
    float* sc_ = (float*)smem + 512;
    const int tid = otid(), lane = tid & 63, wave = tid >> 6;
    for (int i = tid; i < 2048; i += 256) sc_[i] = silu_f(p.c[i]);
    __syncthreads();
    const int nitems = (4 * 6144 + 2048) / 64;
    for (int it = blockIdx.x; it < nitems; it += gridDim.x) {
      int col = it * 64 + lane;
      const float* W;
      const float* bias;
      float* out;
      int N, n;
      if (col < 4 * 6144) {
        int l = col / 6144;
        n = col % 6144;
        W = p.ada_w + (long)l * 1024 * 6144;
        bias = p.ada_b + l * 6144;
        out = p.mods + l * 2 * 6144;
        N = 6144;
      } else {
        n = col - 4 * 6144;
        W = p.kv_ada_w;
        bias = p.kv_ada_b;
        out = p.kvmod;
        N = 2048;
      }
      float a0 = 0.f, a1 = 0.f;
      const float* wp = W + (long)(wave * 256) * N + n;
      const float* c0 = sc_ + wave * 256;
      for (int k = 0; k < 256; k += 16) {
        float w[16];
#pragma unroll
        for (int u = 0; u < 16; u++) w[u] = wp[(long)(k + u) * N];
#pragma unroll
        for (int u = 0; u < 16; u++) {
          a0 += c0[k + u] * w[u];
          a1 += c0[1024 + k + u] * w[u];
        }
      }
      __syncthreads();
      red[(wave * 2 + 0) * 64 + lane] = a0;
      red[(wave * 2 + 1) * 64 + lane] = a1;
      __syncthreads();
      if (wave < 2) {
        float sm = bias[n];
        for (int w = 0; w < 4; w++) sm += red[(w * 2 + wave) * 64 + lane];
        out[wave * N + n] = sm;
      }
    }
  }
  {
    long n = 8192L * 128;
    for (long i = (long)blockIdx.x * 256 + otid(); i < n; i += (long)gridDim.x * 256) {
      int s = (int)(i >> 7), fi = (int)(i & 127);
      float theta = 1.0f / powf(10000.0f, (float)fi / 127.0f);
      float ang = (float)s * theta;
      float sn, cn;
      sincosf(ang, &sn, &cn);
      p.cs[2 * i] = cn;
      p.cs[2 * i + 1] = sn;
    }
  }
  {
    const int tid = otid(), lane = tid & 63, wave = tid >> 6;
    for (int o = blockIdx.x * 4 + wave; o < 512; o += gridDim.x * 4) {
      int c = o >> 8, j = o & 255;
      float sm = 0.f;
      for (int f = lane; f < 2048; f += 64) sm += p.cmp_pe[c * 2048 + f] * p.cmp_w1[((long)c * 2048 + f) * 256 + j];
      sm = wave_allsum(sm);
      if (lane == 0) p.biasp[o] = sm + p.cmp_b1[c * 256 + j];
    }
  }
}

__device__ __forceinline__ void h0_phase(const P& p) {
  long n = (long)T_ * D_;
  for (long i = ((long)blockIdx.x * 256 + otid()) * 8; i < n; i += (long)gridDim.x * 256 * 8) {
    int t = (int)(i >> 10), k = (int)(i & 1023);
    int b = t / S_;
    const float* md = p.mods + b * 6144;
    float4 a = *(const float4*)(p.x + i), bb = *(const float4*)(p.x + i + 4);
    float xv[8] = {a.x, a.y, a.z, a.w, bb.x, bb.y, bb.z, bb.w};
    float h[8];
#pragma unroll
    for (int j = 0; j < 8; j++) h[j] = xv[j] * (1.f + md[1024 + k + j]) + md[k + j];
    *(uint4*)(p.hbuf + i) = make_uint4(pack2(h[0], h[1]), pack2(h[2], h[3]), pack2(h[4], h[5]), pack2(h[6], h[7]));
  }
}

__device__ __forceinline__ void ret_proj_phase(const P& p, int layer, unsigned char* smem) {
  const bf16_t* W = p.retWinT + (long)layer * 6144 * 1024;
  const int ntn = 48, ntm = 64;
  for (int it = blockIdx.x; it < ntn * ntm; it += gridDim.x) {
    int tn = it % ntn, tm = it / ntn;
    f32x16 acc[2][4];
#pragma unroll
    for (int i = 0; i < 2; i++)
#pragma unroll
      for (int j = 0; j < 4; j++)
#pragma unroll
        for (int r = 0; r < 16; r++) acc[i][j][r] = 0.f;
    gemm_tile256(p.hbuf + (long)tm * 256 * 1024, 1024, W + (long)tn * 128 * 1024, 1024, 1024, acc, smem);
    const int m0 = tm * 256;
    const int b = m0 / S_, s0 = m0 % S_;
    if (tn < 16) {
      const bool isK = tn >= 8;
      const int hd = (tn & 7) >> 1, t2 = tn & 1;
      const float lg = log1pf(-exp2f(-5.0f - (float)hd));
      const long bh = b * 4 + hd;
      epi_pairs256(acc, [&](int row0, int col0, const float* v0, const float* v1) {
        int fi = t2 * 64 + col0;
        float o1[4], o2[4];
#pragma unroll
        for (int j = 0; j < 4; j++) {
          int s = s0 + row0 + j;
          float2 cs = *(const float2*)(p.cs + 2 * ((long)s * 128 + fi));
          float x1 = v0[j], x2 = v1[j];
          float r1 = x1 * cs.x - x2 * cs.y, r2 = x1 * cs.y + x2 * cs.x;
          int cpos = s & 127;
          float sc = isK ? 0.0625f * __expf(-(float)(cpos + 1) * lg) : __expf((float)(cpos + 1) * lg);
          o1[j] = r1 * sc;
          o2[j] = r2 * sc;
        }
        int p1 = fi, p2 = 128 + fi;
        bf16_t* dst = isK ? p.Kd : p.Qd;
#pragma unroll
        for (int j = 0; j < 4; j++) {
          long s = s0 + row0 + j;
          dst[(bh * S_ + s) * 256 + p1] = f2bf(o1[j]);
          dst[(bh * S_ + s) * 256 + p2] = f2bf(o2[j]);
        }
        if (isK) {
          long s = s0 + row0;
          *(uint2*)(p.KdT + ((bh * 64 + (s >> 7)) * 256 + p1) * 128 + (s & 127)) = make_uint2(pack2(o1[0], o1[1]), pack2(o1[2], o1[3]));
          *(uint2*)(p.KdT + ((bh * 64 + (s >> 7)) * 256 + p2) * 128 + (s & 127)) = make_uint2(pack2(o2[0], o2[1]), pack2(o2[2], o2[3]));
        }
      });
    } else if (tn < 32) {
      const int hd = (tn - 16) >> 2, e0 = ((tn - 16) & 3) * 128;
      const long bh = b * 4 + hd;
      epi_pairs256(acc, [&](int row0, int col0, const float* v0, const float* v1) {
        long s = s0 + row0;
        *(uint2*)(p.VT + ((bh * 64 + (s >> 7)) * 512 + e0 + col0) * 128 + (s & 127)) = make_uint2(pack2(v0[0], v0[1]), pack2(v0[2], v0[3]));
        *(uint2*)(p.VT + ((bh * 64 + (s >> 7)) * 512 + e0 + col0 + 64) * 128 + (s & 127)) = make_uint2(pack2(v1[0], v1[1]), pack2(v1[2], v1[3]));
      });
    } else {
      const int c0 = (tn - 32) * 128;
      epi_pairs256(acc, [&](int row0, int col0, const float* v0, const float* v1) {
#pragma unroll
        for (int j = 0; j < 4; j++) {
          long t = m0 + row0 + j;
          p.Gs[t * 2048 + c0 + col0] = f2bf(silu_f(v0[j]));
          p.Gs[t * 2048 + c0 + col0 + 64] = f2bf(silu_f(v1[j]));
        }
      });
    }
  }
}

__device__ __forceinline__ void ret_up_phase(const P& p, unsigned char* smem) {
  const int nU = 8 * 64 * 8;
  const int nP = 8 * 64;
  for (int it0 = blockIdx.x; it0 < nU + nP; it0 += gridDim.x) {
    const int it = item_swz(it0, nU + nP);
    f32x16 acc[2][2];
    zero_acc(acc);
    if (it < nU) {
      int sub = it & 7, n = (it >> 3) & 63, bh = it >> 9;
      int et = sub >> 1, dt = sub & 1;
      gemm_tile(p.VT + ((long)(bh * 64 + n) * 512 + et * 128) * 128, 128, p.KdT + ((long)(bh * 64 + n) * 256 + dt * 128) * 128, 128,
                128, acc, smem);
      bf16_t* dst = p.ST + ((long)(bh * 64 + n) * 512 + et * 128) * 256 + dt * 128;
      epi_pairs(acc, [&](int row0, int col0, const float* v0, const float* v1) {
#pragma unroll
        for (int j = 0; j < 4; j++) {
          dst[(long)(row0 + j) * 256 + col0] = f2bf(v0[j]);
          dst[(long)(row0 + j) * 256 + col0 + 64] = f2bf(v1[j]);
        }
      });
    } else {
      int i2 = it - nU;
      int n = i2 & 63, bh = i2 >> 6;
      gemm_tile(p.Qd + ((long)bh * S_ + n * 128) * 256, 256, p.Kd + ((long)bh * S_ + n * 128) * 256, 256, 256, acc, smem);
      bf16_t* dst = p.Pb + (long)(bh * 64 + n) * 128 * 128;
      epi_pairs(acc, [&](int row0, int col0, const float* v0, const float* v1) {
#pragma unroll
        for (int j = 0; j < 4; j++) {
          int r = row0 + j;
          dst[r * 128 + col0] = f2bf(r >= col0 ? v0[j] : 0.f);
          dst[r * 128 + col0 + 64] = f2bf(r >= col0 + 64 ? v1[j] : 0.f);
        }
      });
    }
  }
}

__device__ __forceinline__ void ret_scan_phase(const P& p) {
  const long per = 512L * 256;
  long total = 8L * per / 8;
  for (long i = (long)blockIdx.x * 256 + otid(); i < total; i += (long)gridDim.x * 256) {
    long e = i * 8;
    int bh = (int)(e / per);
    long off = e % per;
    int hd = bh & 3;
    float cdec = __expf(128.f * log1pf(-exp2f(-5.0f - (float)hd)));
    float st[8];
#pragma unroll
    for (int j = 0; j < 8; j++) st[j] = 0.f;
    bf16_t* base = p.ST + (long)bh * 64 * per + off;
    uint4 u = *(const uint4*)base;
    for (int n = 0; n < 64; n++) {
      uint4 un = u;
      if (n + 1 < 64) un = *(const uint4*)(base + (long)(n + 1) * per);
      *(uint4*)(base + (long)n * per) = make_uint4(pack2(st[0], st[1]), pack2(st[2], st[3]), pack2(st[4], st[5]), pack2(st[6], st[7]));
      unsigned w[4] = {u.x, u.y, u.z, u.w};
#pragma unroll
      for (int j = 0; j < 4; j++) {
        st[2 * j] = cdec * (st[2 * j] + __uint_as_float(w[j] << 16));
        st[2 * j + 1] = cdec * (st[2 * j + 1] + __uint_as_float(w[j] & 0xffff0000u));
      }
      u = un;
    }
  }
}

__device__ __forceinline__ void ret_out_phase(const P& p, unsigned char* smem) {
  const int nitems = 8 * 64 * 4;
  for (int it0 = blockIdx.x; it0 < nitems; it0 += gridDim.x) {
    const int it = item_swz(it0, nitems);
    int et = it & 3, n = (it >> 2) & 63, bh = it >> 8;
    int b = bh >> 2, hd = bh & 3;
    f32x16 acc[2][2];
    zero_acc(acc);
    gemm_tile(p.Pb + (long)(bh * 64 + n) * 128 * 128, 128, p.VT + ((long)(bh * 64 + n) * 512 + et * 128) * 128, 128, 128, acc, smem);
    gemm_tile(p.Qd + ((long)bh * S_ + n * 128) * 256, 256, p.ST + ((long)(bh * 64 + n) * 512 + et * 128) * 256, 256, 256, acc, smem);
    bf16_t* dst = p.Ob + ((long)b * S_ + n * 128) * 2048 + hd * 512 + et * 128;
    epi_pairs(acc, [&](int row0, int col0, const float* v0, const float* v1) {
#pragma unroll
      for (int j = 0; j < 4; j++) {
        dst[(long)(row0 + j) * 2048 + col0] = f2bf(v0[j]);
        dst[(long)(row0 + j) * 2048 + col0 + 64] = f2bf(v1[j]);
      }
    });
  }
}

__device__ __forceinline__ void ret_gn_phase(const P& p) {
  const int tid_ = otid(); const int lane = tid_ & 63, wave = tid_ >> 6;
  for (int t = blockIdx.x * 4 + wave; t < T_; t += gridDim.x * 4) {
#pragma unroll
    for (int hd = 0; hd < 4; hd++) {
      long off = (long)t * 2048 + hd * 512 + lane * 8;
      uint4 o = *(const uint4*)(p.Ob + off);
      uint4 g = *(const uint4*)(p.Gs + off);
      unsigned ow[4] = {o.x, o.y, o.z, o.w}, gw[4] = {g.x, g.y, g.z, g.w};
      float ov[8], gv[8];
#pragma unroll
      for (int j = 0; j < 4; j++) {
        ov[2 * j] = __uint_as_float(ow[j] << 16);
        ov[2 * j + 1] = __uint_as_float(ow[j] & 0xffff0000u);
        gv[2 * j] = __uint_as_float(gw[j] << 16);
        gv[2 * j + 1] = __uint_as_float(gw[j] & 0xffff0000u);
      }
      float s = 0.f;
#pragma unroll
      for (int j = 0; j < 8; j++) s += ov[j];
      float mu = wave_allsum(s) * (1.f / 512.f);
      float q = 0.f;
#pragma unroll
      for (int j = 0; j < 8; j++) q += (ov[j] - mu) * (ov[j] - mu);
      float rstd = rsqrtf(wave_allsum(q) * (1.f / 512.f) + LN_EPS_);
      float r[8];
#pragma unroll
      for (int j = 0; j < 8; j++) r[j] = gv[j] * (ov[j] - mu) * rstd;
      *(uint4*)(p.Gs + off) = make_uint4(pack2(r[0], r[1]), pack2(r[2], r[3]), pack2(r[4], r[5]), pack2(r[6], r[7]));
    }
  }
}

__device__ __forceinline__ void wo_phase(const P& p, int layer, const bf16_t* A, const bf16_t* WoT, int K, unsigned char* smem) {
  const float* xres = layer == 0 ? p.x : p.xbuf;
  const int ntn = 8, ntm = 64;
#pragma unroll 1
  for (int it = blockIdx.x; it < ntn * ntm; it += gridDim.x) {
    int tn, tm;
    tile_map(it, ntm, ntn, 1, tm, tn);
    f32x16 acc[2][4];
#pragma unroll
    for (int i = 0; i < 2; i++)
#pragma unroll
      for (int j = 0; j < 4; j++)
#pragma unroll
        for (int r = 0; r < 16; r++) acc[i][j][r] = 0.f;
    gemm_tile256(A + (long)tm * 256 * K, K, WoT + (long)tn * 128 * K, K, K, acc, smem);
    const int m0 = tm * 256, n0 = tn * 128;
    const int b = m0 / S_;
    const float* g1 = p.mods + (layer * 2 + b) * 6144 + 2048;
    epi_pairs256(acc, [&](int row0, int col0, const float* v0, const float* v1) {
      int c = n0 + col0;
      float ga = g1[c], gb = g1[c + 64];
#pragma unroll
      for (int j = 0; j < 4; j++) {
        long o = (long)(m0 + row0 + j) * 1024 + c;
        p.xbuf[o] = ALPHA_ * xres[o] + ga * v0[j];
        p.xbuf[o + 64] = ALPHA_ * xres[o + 64] + gb * v1[j];
      }
    });
  }
}

__device__ __forceinline__ void ln1_phase(const P& p, int layer) {
  const int tid_ = otid(); const int lane = tid_ & 63, wave = tid_ >> 6;
  const float* lg = p.ln_g + (layer * 2 + 0) * 1024;
  const float* lb = p.ln_b + (layer * 2 + 0) * 1024;
  for (int t = blockIdx.x * 4 + wave; t < T_; t += gridDim.x * 4) {
    int b = t / S_;
    const float* md = p.mods + (layer * 2 + b) * 6144;
    float* xr = p.xbuf + (long)t * 1024;
    float z[16];
#pragma unroll
    for (int j = 0; j < 2; j++) {
      float4 a = *(const float4*)(xr + j * 512 + lane * 8), bq = *(const float4*)(xr + j * 512 + lane * 8 + 4);
      z[j * 8 + 0] = a.x; z[j * 8 + 1] = a.y; z[j * 8 + 2] = a.z; z[j * 8 + 3] = a.w;
      z[j * 8 + 4] = bq.x; z[j * 8 + 5] = bq.y; z[j * 8 + 6] = bq.z; z[j * 8 + 7] = bq.w;
    }
    float s = 0.f;
#pragma unroll
    for (int j = 0; j < 16; j++) s += z[j];
    float mu = wave_allsum(s) * (1.f / 1024.f);
    float q = 0.f;
#pragma unroll
    for (int j = 0; j < 16; j++) q += (z[j] - mu) * (z[j] - mu);
    float rstd = rsqrtf(wave_allsum(q) * (1.f / 1024.f) + LN_EPS_);
#pragma unroll
    for (int j = 0; j < 2; j++) {
      int k0 = j * 512 + lane * 8;
      float xo[8], h[8];
#pragma unroll
      for (int i = 0; i < 8; i++) {
        xo[i] = (z[j * 8 + i] - mu) * rstd * lg[k0 + i] + lb[k0 + i];
        h[i] = xo[i] * (1.f + md[4 * 1024 + k0 + i]) + md[3 * 1024 + k0 + i];
      }
      *(float4*)(xr + k0) = make_float4(xo[0], xo[1], xo[2], xo[3]);
      *(float4*)(xr + k0 + 4) = make_float4(xo[4], xo[5], xo[6], xo[7]);
      *(uint4*)(p.hbuf + (long)t * 1024 + k0) = make_uint4(pack2(h[0], h[1]), pack2(h[2], h[3]), pack2(h[4], h[5]), pack2(h[6], h[7]));
    }
  }
}

#define KSTR 132
__device__ __forceinline__ void peer_qscore_phase(const P& p, int layer, unsigned char* smem) {
  const bf16_t* W = p.wqT + (long)layer * 2048 * 1024;
  const bf16_t* keys = p.keysB + (long)layer * 16 * 128 * 128;
  bf16_t* sKeys = (bf16_t*)smem;
#pragma unroll 1
  for (int it = blockIdx.x; it < 16 * 128; it += gridDim.x) {
    int hc, tm;
    tile_map(it, 128, 16, 2, tm, hc);
    f32x16 acc[4];
#pragma unroll
    for (int i = 0; i < 4; i++)
#pragma unroll
      for (int r = 0; r < 16; r++) acc[i][r] = 0.f;
    gemm_tile_w41(W + (long)hc * 128 * 1024, 1024, p.hbuf + (long)tm * 128 * 1024, 1024, 1024, acc, smem);
    const int tid = otid(), lane = tid & 63, wave = tid >> 6, hf = lane >> 5;
    {
      const bf16_t* kg = keys + (long)hc * 128 * 128;
#pragma unroll
      for (int i = 0; i < 8; i++) {
        int ch = tid + i * 256;
        int r = ch >> 4, c = (ch & 15) * 8;
        uint4 v = *(const uint4*)(kg + r * 128 + c);
        *(uint2*)(sKeys + r * KSTR + c) = make_uint2(v.x, v.y);
        *(uint2*)(sKeys + r * KSTR + c + 4) = make_uint2(v.z, v.w);
      }
    }
    bf16x8 qb[8];
#pragma unroll
    for (int i2 = 0; i2 < 8; i2++) {
      const int mi = i2 >> 1, u = i2 & 1;
      union { unsigned w[4]; bf16x8 v; } pf;
#pragma unroll
      for (int j = 0; j < 4; j++) pf.w[j] = pack2(acc[mi][8 * u + 2 * j], acc[mi][8 * u + 2 * j + 1]);
      qb[i2] = pf.v;
    }
    __syncthreads();
    f32x16 sc[4];
#pragma unroll
    for (int kt = 0; kt < 4; kt++) {
#pragma unroll
      for (int r = 0; r < 16; r++) sc[kt][r] = 0.f;
#pragma unroll
      for (int i2 = 0; i2 < 8; i2++) {
        const bf16_t* kp = sKeys + (kt * 32 + (lane & 31)) * KSTR + i2 * 16 + hf * 4;
        uint2 lo = *(const uint2*)kp, hi = *(const uint2*)(kp + 8);
        union { unsigned w[4]; bf16x8 v; } kf;
        kf.w[0] = lo.x; kf.w[1] = lo.y; kf.w[2] = hi.x; kf.w[3] = hi.y;
        sc[kt] = mfma32(kf.v, qb[i2], sc[kt]);
      }
    }
    float top[16];
#pragma unroll
    for (int i = 0; i < 16; i++) top[i] = -3.0e38f;
    const int jb = 127 - hf * 4;
#pragma unroll
    for (int kt = 0; kt < 4; kt++)
#pragma unroll
      for (int r = 0; r < 16; r++) {
        const int jc = kt * 32 + (r >> 2) * 8 + (r & 3);
        float x = __int_as_float((__float_as_int(sc[kt][r]) & ~127) | (jb - jc));
#pragma unroll
        for (int i = 15; i >= 1; i--) top[i] = __builtin_amdgcn_fmed3f(top[i - 1], top[i], x);
        top[0] = fmaxf(top[0], x);
      }
    float oth[16];
#pragma unroll
    for (int i = 0; i < 16; i++) oth[i] = __shfl_xor(top[i], 32);
#pragma unroll
    for (int k = 0; k < 16; k++) {
      float x = oth[k];
#pragma unroll
      for (int i = 15; i >= 1; i--) top[i] = __builtin_amdgcn_fmed3f(top[i - 1], top[i], x);
      top[0] = fmaxf(top[0], x);
    }
    if (hf == 0) {
      const int token = tm * 128 + wave * 32 + lane;
      float4* d = (float4*)(p.topk + ((long)token * 16 + hc) * 16);
      d[0] = make_float4(top[0], top[1], top[2], top[3]);
      d[1] = make_float4(top[4], top[5], top[6], top[7]);
      d[2] = make_float4(top[8], top[9], top[10], top[11]);
      d[3] = make_float4(top[12], top[13], top[14], top[15]);
    }
  }
}

__device__ __forceinline__ void expert_dot(const int4& uq, const f32x2 (&h2)[8], float& d) {
  f32x2 acc = {0.f, 0.f};
  const int uw[4] = {uq.x, uq.y, uq.z, uq.w};
#pragma unroll
  for (int q = 0; q < 4; q++) {
    acc = __builtin_elementwise_fma(__builtin_amdgcn_cvt_pk_f32_fp8(uw[q], false), h2[2 * q], acc);
    acc = __builtin_elementwise_fma(__builtin_amdgcn_cvt_pk_f32_fp8(uw[q], true), h2[2 * q + 1], acc);
  }
  d = acc.x + acc.y;
}
__device__ __forceinline__ void expert_axpy(const int4& vq, float a, f32x2 (&y2)[8]) {
  const int vw[4] = {vq.x, vq.y, vq.z, vq.w};
  const f32x2 a2 = {a, a};
#pragma unroll
  for (int q = 0; q < 4; q++) {
    y2[2 * q] = __builtin_elementwise_fma(__builtin_amdgcn_cvt_pk_f32_fp8(vw[q], false), a2, y2[2 * q]);
    y2[2 * q + 1] = __builtin_elementwise_fma(__builtin_amdgcn_cvt_pk_f32_fp8(vw[q], true), a2, y2[2 * q + 1]);
  }
}
#define EXG 4
__device__ __forceinline__ void peer_expert_phase(const P& p, int layer, unsigned char* smem, const bool dry) {
  const int tid_ = otid();
  const int lane = tid_ & 63, wave = tid_ >> 6;
  int4* elist = (int4*)smem + wave * 128;
  int* tkl = (int*)(smem + 8192) + wave * 256;
  int ci = 0, cj = 0, cnt = 0;
  bool isc = false;
  for (int i = 0; i < 16; i++)
    for (int j = 0; j < 16; j++)
      if ((i + 1) * (j + 1) <= 16) {
        if (cnt == lane) { ci = i; cj = j; isc = true; }
        cnt++;
      }
  const unsigned char* U = p.uB + (long)layer * 16384 * 2048;
  const unsigned char* V = U + 1024;
  const float* SU = p.su + layer * 16384;
  const float* SV = p.sv + layer * 16384;
  const float* lg = p.ln_g + (layer * 2 + 1) * 1024;
  const float* lb = p.ln_b + (layer * 2 + 1) * 1024;
  __syncthreads();
#pragma unroll 1
  for (int t = blockIdx.x * 4 + wave; t < T_; t += gridDim.x * 4) {
    int b = t / S_;
    const float* md = p.mods + (layer * 2 + b) * 6144;
    float* xr = p.xbuf + (long)t * 1024;
    float xv[16];
    f32x2 h2[8];
#pragma unroll
    for (int j = 0; j < 2; j++) {
      float4 a = *(const float4*)(xr + j * 512 + lane * 8), bq = *(const float4*)(xr + j * 512 + lane * 8 + 4);
      xv[j * 8 + 0] = a.x; xv[j * 8 + 1] = a.y; xv[j * 8 + 2] = a.z; xv[j * 8 + 3] = a.w;
      xv[j * 8 + 4] = bq.x; xv[j * 8 + 5] = bq.y; xv[j * 8 + 6] = bq.z; xv[j * 8 + 7] = bq.w;
    }
#pragma unroll
    for (int j = 0; j < 2; j++)
#pragma unroll
      for (int i = 0; i < 8; i += 2) {
        int k = j * 512 + lane * 8 + i;
        f32x2 hh;
        hh.x = xv[j * 8 + i] * (1.f + md[4 * 1024 + k]) + md[3 * 1024 + k];
        hh.y = xv[j * 8 + i + 1] * (1.f + md[4 * 1024 + k + 1]) + md[3 * 1024 + k + 1];
        h2[(j * 8 + i) >> 1] = hh;
      }
    ((int4*)tkl)[lane] = ((const int4*)(p.topk + (long)t * 256))[lane];
    __builtin_amdgcn_wave_barrier();
#pragma unroll 1
    for (int head = 0; head < 8; head++) {
      int key = 0;
      if (lane < 32) key = tkl[head * 32 + lane];
      int k0 = __shfl(key, ci), k1 = __shfl(key, 16 + cj);
      float s = isc ? (__int_as_float(k0 & ~127) + __int_as_float(k1 & ~127)) : -3.0e38f;
      int rank = 0;
#pragma unroll
      for (int c2 = 0; c2 < 50; c2++) {
        float s2 = __int_as_float(__builtin_amdgcn_readlane(__float_as_int(s), c2));
        rank += (s2 > s || (s2 == s && c2 < lane)) ? 1 : 0;
      }
      bool sel = isc && rank < 16;
      unsigned long long b0 = __ballot(isc && rank == 0);
      int l0 = __ffsll((long long)b0) - 1;
      float mx = __shfl(s, l0);
      float w = sel ? __expf(s - mx) : 0.f;
      float tot = wave_allsum_fast(w);
      w = w / tot;
      if (sel) {
        int e = (127 - (k0 & 127)) * 128 + (127 - (k1 & 127));
        elist[head * 16 + rank] = make_int4(e, __float_as_int(w), 0, 0);
      }
    }
    __builtin_amdgcn_wave_barrier();
    f32x2 y2[8];
#pragma unroll
    for (int i = 0; i < 8; i++) y2[i] = (f32x2){0.f, 0.f};
    int4 ua[EXG], va[EXG], ub[EXG], vb[EXG];
#pragma unroll
    for (int i = 0; i < EXG; i++) {
      int e = elist[i].x;
      ua[i] = *((const int4*)(U + (long)e * 2048) + lane);
      va[i] = *((const int4*)(V + (long)e * 2048) + lane);
    }
    {
      int e0 = elist[lane].x, e1 = elist[lane + 64].x;
      float su0 = SU[e0], sv0 = SV[e0], su1 = SU[e1], sv1 = SV[e1];
      elist[lane].z = __float_as_int(su0);
      elist[lane].w = __float_as_int(sv0);
      elist[lane + 64].z = __float_as_int(su1);
      elist[lane + 64].w = __float_as_int(sv1);
    }
    __builtin_amdgcn_wave_barrier();
#pragma unroll 1
    for (int g = 0; g < 128 / EXG; g += 2) {
#pragma unroll
      for (int i = 0; i < EXG; i++) {
        int e = elist[(g + 1) * EXG + i].x;
        ub[i] = *((const int4*)(U + (long)e * 2048) + lane);
        vb[i] = *((const int4*)(V + (long)e * 2048) + lane);
      }
#pragma unroll
      for (int i = 0; i < EXG; i++) {
        int4 ew = elist[g * EXG + i];
        float d;
        expert_dot(ua[i], h2, d);
        d = wave_allsum_fast(d) * __int_as_float(ew.z);
        float a = gelu_t(d) * __int_as_float(ew.y) * __int_as_float(ew.w);
        expert_axpy(va[i], a, y2);
      }
      if (g + 2 < 128 / EXG) {
#pragma unroll
        for (int i = 0; i < EXG; i++) {
          int e = elist[(g + 2) * EXG + i].x;
          ua[i] = *((const int4*)(U + (long)e * 2048) + lane);
          va[i] = *((const int4*)(V + (long)e * 2048) + lane);
        }
      }
#pragma unroll
      for (int i = 0; i < EXG; i++) {
        int4 ew = elist[(g + 1) * EXG + i];
        float d;
        expert_dot(ub[i], h2, d);
        d = wave_allsum_fast(d) * __int_as_float(ew.z);
        float a = gelu_t(d) * __int_as_float(ew.y) * __int_as_float(ew.w);
        expert_axpy(vb[i], a, y2);
      }
    }
    __builtin_amdgcn_wave_barrier();
    float z[16];
    float s = 0.f;
#pragma unroll
    for (int j = 0; j < 2; j++)
#pragma unroll
      for (int i = 0; i < 8; i++) {
        int k = j * 512 + lane * 8 + i;
        float yv = (i & 1) ? y2[(j * 8 + i) >> 1].y : y2[(j * 8 + i) >> 1].x;
        z[j * 8 + i] = ALPHA_ * xv[j * 8 + i] + md[5 * 1024 + k] * yv;
        s += z[j * 8 + i];
      }
    float mu = wave_allsum_fast(s) * (1.f / 1024.f);
    float q = 0.f;
#pragma unroll
    for (int j = 0; j < 16; j++) q += (z[j] - mu) * (z[j] - mu);
    float rstd = rsqrtf(wave_allsum_fast(q) * (1.f / 1024.f) + LN_EPS_);
    float* dstx = dry ? ((float*)p.qp + (long)t * 1024) : ((layer == 3) ? (p.out + (long)t * 1024) : xr);
    const float* mdn = p.mods + (((layer + 1) & 3) * 2 + b) * 6144;
    const float* kvm = p.kvmod + b * 2048;
#pragma unroll
    for (int j = 0; j < 2; j++) {
      int k0 = j * 512 + lane * 8;
      float xo[8], h[8], xs[8];
#pragma unroll
      for (int i = 0; i < 8; i++) {
        xo[i] = (z[j * 8 + i] - mu) * rstd * lg[k0 + i] + lb[k0 + i];
        h[i] = xo[i] * (1.f + mdn[1024 + k0 + i]) + mdn[k0 + i];
        xs[i] = xo[i] * (1.f + kvm[1024 + k0 + i]) + kvm[k0 + i];
      }
      *(float4*)(dstx + k0) = make_float4(xo[0], xo[1], xo[2], xo[3]);
      *(float4*)(dstx + k0 + 4) = make_float4(xo[4], xo[5], xo[6], xo[7]);
      if (layer < 3 && !dry)
        *(uint4*)(p.hbuf + (long)t * 1024 + k0) = make_uint4(pack2(h[0], h[1]), pack2(h[2], h[3]), pack2(h[4], h[5]), pack2(h[6], h[7]));
      if (layer == 1 && !dry)
        *(uint4*)(p.xsbuf + (long)t * 1024 + k0) = make_uint4(pack2(xs[0], xs[1]), pack2(xs[2], xs[3]), pack2(xs[4], xs[5]), pack2(xs[6], xs[7]));
    }
  }
}

__device__ __forceinline__ void kv_proj_phase(const P& p, unsigned char* smem) {
  const int ntn = 12, ntm = 128;
  const long partsz = 8L * S_ * 64;
  for (int it = blockIdx.x; it < ntn * ntm; it += gridDim.x) {
    int tn, tm;
    tile_map(it, ntm, ntn, 1, tm, tn);
    f32x16 acc[2][2];
    zero_acc(acc);
    gemm_tile(p.xsbuf + (long)tm * 128 * 1024, 1024, p.kvWT + (long)tn * 128 * 1024, 1024, 1024, acc, smem);
    const int m0 = tm * 128, b = m0 / S_, s0 = m0 % S_;
    const int part = tn >> 1, ga = (tn & 1) * 2;
    bf16_t* base = p.kvbuf + part * partsz;
    const bool tr = (part == 3 || part == 5);
    epi_pairs(acc, [&](int row0, int col0, const float* v0, const float* v1) {
      long bg0 = b * 4 + ga, bg1 = bg0 + 1;
      int d = col0;
      long s = s0 + row0;
      if (tr) {
        *(uint2*)(base + ((bg0 * 64 + (s >> 7)) * 64 + d) * 128 + (s & 127)) = make_uint2(pack2(v0[0], v0[1]), pack2(v0[2], v0[3]));
        *(uint2*)(base + ((bg1 * 64 + (s >> 7)) * 64 + d) * 128 + (s & 127)) = make_uint2(pack2(v1[0], v1[1]), pack2(v1[2], v1[3]));
      } else {
#pragma unroll
        for (int j = 0; j < 4; j++) {
          base[(bg0 * S_ + s + j) * 64 + d] = f2bf(v0[j]);
          base[(bg1 * S_ + s + j) * 64 + d] = f2bf(v1[j]);
        }
      }
    });
  }
}

__device__ __forceinline__ void cmp1_phase(const P& p, unsigned char* smem) {
  const long partsz = 8L * S_ * 64;
  for (int it0 = blockIdx.x; it0 < 2 * 8 * 4 * 2; it0 += gridDim.x) {
    const int it = item_swz(it0, 2 * 8 * 4 * 2);
    int tn = it & 1, tm = (it >> 1) & 3, bg = (it >> 3) & 7, c = it >> 6;
    f32x16 acc[2][2];
    zero_acc(acc);
    gemm_tile(p.kvbuf + c * partsz + (long)bg * S_ * 64 + (long)tm * 128 * 1024, 1024, p.w1T + ((long)c * 256 + tn * 128) * 2048, 2048,
              2048, acc, smem);
    bf16_t* dst = p.hid + ((long)(c * 8 + bg) * 512 + tm * 128) * 256 + tn * 128;
    const float* bp = p.biasp + c * 256 + tn * 128;
    epi_pairs(acc, [&](int row0, int col0, const float* v0, const float* v1) {
      float ba = bp[col0], bb = bp[col0 + 64];
#pragma unroll
      for (int j = 0; j < 4; j++) {
        dst[(long)(row0 + j) * 256 + col0] = f2bf(gelu_t(v0[j] + ba));
        dst[(long)(row0 + j) * 256 + col0 + 64] = f2bf(gelu_t(v1[j] + bb));
      }
    });
  }
}

__device__ __forceinline__ void cmp2_phase(const P& p, unsigned char* smem) {
  for (int it = blockIdx.x; it < 2 * 8 * 4; it += gridDim.x) {
    int tm = it & 3, bg = (it >> 2) & 7, c = it >> 5;
    f32x16 acc[2][2];
    zero_acc(acc);
    gemm_tile(p.hid + ((long)(c * 8 + bg) * 512 + tm * 128) * 256, 256, p.w2T + (long)c * 128 * 256, 256, 256, acc, smem);
    epi_pairs(acc, [&](int row0, int col0, const float* v0, const float* v1) {
      int n = tm * 128 + row0;
      if (c == 0) {
#pragma unroll
        for (int j = 0; j < 4; j++) p.Kc[((long)bg * 512 + n + j) * 64 + col0] = f2bf(v0[j]);
      } else {
        *(uint2*)(p.VcT + ((long)bg * 64 + col0) * 512 + n) = make_uint2(pack2(v0[0], v0[1]), pack2(v0[2], v0[3]));
      }
    });
  }
}

__device__ __forceinline__ void nsa_q_phase(const P& p, int lb, unsigned char* smem) {
  const bf16_t* W = p.nsaWinT + (long)lb * 1152 * 1024;
  const int ntn = 9, ntm = 128;
  for (int it = blockIdx.x; it < ntn * ntm; it += gridDim.x) {
    int tn, tm;
    tile_map(it, ntm, ntn, 1, tm, tn);
    f32x16 acc[2][2];
    zero_acc(acc);
    gemm_tile(p.hbuf + (long)tm * 128 * 1024, 1024, W + (long)tn * 128 * 1024, 1024, 1024, acc, smem);
    const int m0 = tm * 128, n0 = tn * 128;
    epi_pairs(acc, [&](int row0, int col0, const float* v0, const float* v1) {
#pragma unroll
      for (int j = 0; j < 4; j++) {
        long t = m0 + row0 + j;
        int ca = n0 + col0, cb = ca + 64;
        if (ca < 1024) p.Qn[t * 1024 + ca] = f2bf(v0[j] * 0.18033688011112042f);
        else if (ca < 1072) p.gate[t * 48 + ca - 1024] = sigmoid_f(v0[j]);
        if (cb < 1024) p.Qn[t * 1024 + cb] = f2bf(v1[j] * 0.18033688011112042f);
        else if (cb < 1072) p.gate[t * 48 + cb - 1024] = sigmoid_f(v1[j]);
      }
    });
  }
}

#define VSTR 132
__device__ __forceinline__ void stage_K(const bf16_t* __restrict__ src, bf16_t* sK) {
  const int tid = otid();
#pragma unroll
  for (int i = 0; i < 4; i++) {
    int ch = tid + i * 256;
    int r = ch >> 3, c = (ch & 7) * 8;
    *(uint4*)(sK + r * LSTR + c) = *(const uint4*)(src + r * 64 + c);
  }
}
__device__ __forceinline__ void stage_VT(const bf16_t* __restrict__ src, long ld, bf16_t* sV) {
  const int tid = otid();
#pragma unroll
  for (int i = 0; i < 4; i++) {
    int ch = tid + i * 256;
    int r = ch >> 4, c = (ch & 15) * 8;
    uint4 v = *(const uint4*)(src + (long)r * ld + c);
    *(uint2*)(sV + r * VSTR + c) = make_uint2(v.x, v.y);
    *(uint2*)(sV + r * VSTR + c + 4) = make_uint2(v.z, v.w);
  }
}
__device__ __forceinline__ void attn_qk(const bf16_t* sK, const bf16x8 (&qf)[4], f32x16 (&st)[2], int lane) {
#pragma unroll
  for (int mi = 0; mi < 2; mi++) {
#pragma unroll
    for (int r = 0; r < 16; r++) st[mi][r] = 0.f;
#pragma unroll
    for (int kk = 0; kk < 4; kk++) {
      bf16x8 kf = *(const bf16x8*)(sK + (mi * 32 + (lane & 31)) * LSTR + kk * 16 + (lane >> 5) * 8);
      st[mi] = mfma32(kf, qf[kk], st[mi]);
    }
  }
}
__device__ __forceinline__ void attn_pv(const bf16_t* sV, const f32x16 (&pt)[2], f32x16 (&o)[2], int lane) {
#pragma unroll
  for (int i2 = 0; i2 < 4; i2++) {
    const int mi = i2 >> 1, u = i2 & 1;
    union { unsigned w[4]; bf16x8 v; } pf;
#pragma unroll
    for (int j = 0; j < 4; j++) pf.w[j] = pack2(pt[mi][8 * u + 2 * j], pt[mi][8 * u + 2 * j + 1]);
#pragma unroll
    for (int di = 0; di < 2; di++) {
      const bf16_t* vp = sV + (di * 32 + (lane & 31)) * VSTR + i2 * 16 + (lane >> 5) * 4;
      uint2 lo = *(const uint2*)vp, hi = *(const uint2*)(vp + 8);
      union { unsigned w[4]; bf16x8 v; } vf;
      vf.w[0] = lo.x; vf.w[1] = lo.y; vf.w[2] = hi.x; vf.w[3] = hi.y;
      o[di] = mfma32(vf.v, pf.v, o[di]);
    }
  }
}
__device__ __forceinline__ void add_out(unsigned (&outp)[2][8], const f32x16 (&o)[2], float sc) {
#pragma unroll
  for (int di = 0; di < 2; di++)
#pragma unroll
    for (int j = 0; j < 8; j++) {
      float a = __uint_as_float(outp[di][j] << 16) + sc * o[di][2 * j];
      float b = __uint_as_float(outp[di][j] & 0xffff0000u) + sc * o[di][2 * j + 1];
      outp[di][j] = pack2(a, b);
    }
}
__device__ __forceinline__ void flash_branch(const int MODE, const bf16_t* __restrict__ Kg, const bf16_t* __restrict__ VTg, int kt_lo, int kt_hi,
                                             const bf16x8 (&qf)[4], int t, int q0, const unsigned* sSelq,
                                             float gate, unsigned (&outp)[2][8], bf16_t* sK, bf16_t* sV, int lane) {
  float m = -1e30f, l = 0.f;
  f32x16 o[2];
#pragma unroll
  for (int di = 0; di < 2; di++)
#pragma unroll
    for (int r = 0; r < 16; r++) o[di][r] = 0.f;
  const int tid = otid();
  lane = tid & 63;
  const int hf = lane >> 5;
  const int wlo = (MODE == 2) ? (q0 + 31 - 512) : -1;
  uint4 k_0, k_1, k_2, k_3, v_0, v_1, v_2, v_3;
  const bf16_t* kp = Kg + (long)(tid >> 3) * 64 + (tid & 7) * 8;
  const bf16_t* vp = VTg + (long)(tid >> 4) * 128 + (tid & 15) * 8;
  bf16_t* skw = sK + (tid >> 3) * LSTR + (tid & 7) * 8;
  bf16_t* svw = sV + (tid >> 4) * VSTR + (tid & 15) * 8;
#define FB_LOAD(KT)                                                    \
  k_0 = *(const uint4*)(kp + (long)(KT) * 8192);                       \
  k_1 = *(const uint4*)(kp + (long)(KT) * 8192 + 32 * 64);             \
  k_2 = *(const uint4*)(kp + (long)(KT) * 8192 + 64 * 64);             \
  k_3 = *(const uint4*)(kp + (long)(KT) * 8192 + 96 * 64);             \
  v_0 = *(const uint4*)(vp + (long)(KT) * 8192);                       \
  v_1 = *(const uint4*)(vp + (long)(KT) * 8192 + 16 * 128);            \
  v_2 = *(const uint4*)(vp + (long)(KT) * 8192 + 32 * 128);            \
  v_3 = *(const uint4*)(vp + (long)(KT) * 8192 + 48 * 128);
#define FB_STORE()                                                     \
  *(uint4*)(skw) = k_0;                                                \
  *(uint4*)(skw + 32 * LSTR) = k_1;                                    \
  *(uint4*)(skw + 64 * LSTR) = k_2;                                    \
  *(uint4*)(skw + 96 * LSTR) = k_3;                                    \
  *(uint2*)(svw) = make_uint2(v_0.x, v_0.y);                           \
  *(uint2*)(svw + 4) = make_uint2(v_0.z, v_0.w);                       \
  *(uint2*)(svw + 16 * VSTR) = make_uint2(v_1.x, v_1.y);               \
  *(uint2*)(svw + 16 * VSTR + 4) = make_uint2(v_1.z, v_1.w);           \
  *(uint2*)(svw + 32 * VSTR) = make_uint2(v_2.x, v_2.y);               \
  *(uint2*)(svw + 32 * VSTR + 4) = make_uint2(v_2.z, v_2.w);           \
  *(uint2*)(svw + 48 * VSTR) = make_uint2(v_3.x, v_3.y);               \
  *(uint2*)(svw + 48 * VSTR + 4) = make_uint2(v_3.z, v_3.w);
  FB_LOAD(kt_lo);
#pragma unroll 1
  for (int kt = kt_lo; kt <= kt_hi; kt++) {
    unsigned two = 3u;
    if (MODE == 1) {
      unsigned wsel = sSelq[kt >> 4];
      two = (wsel >> ((2 * kt) & 31)) & 3u;
    }
    __syncthreads();
    FB_STORE();
    __syncthreads();
    if (kt < kt_hi) { FB_LOAD(kt + 1); }
#pragma unroll
    for (int half = 0; half < 2; half++) {
      f32x16 st[2];
      attn_qk(sK + half * 64 * LSTR, qf, st, lane);
      const bool bsel = (two >> half) & 1u;
      const int kbase = kt * 128 + half * 64;
      const bool interior = (kbase + 63 <= q0) && (kbase > wlo);
      float mnew, corr;
      if (interior) {
        float mx = st[0][0];
#pragma unroll
        for (int mi = 0; mi < 2; mi++)
#pragma unroll
          for (int r = 0; r < 16; r++) mx = fmaxf(mx, st[mi][r]);
        mx = bsel ? mx : -1e30f;
        mx = fmaxf(mx, __shfl_xor(mx, 32));
        mnew = fmaxf(m, mx);
        corr = ex2(m - mnew);
        const float c = bsel ? -mnew : -1e30f;
        const f32x2 c2 = {c, c};
        f32x2 ls2 = {0.f, 0.f};
#pragma unroll
        for (int mi = 0; mi < 2; mi++)
#pragma unroll
          for (int r = 0; r < 16; r += 2) {
            f32x2 v = {st[mi][r], st[mi][r + 1]};
            v = v + c2;
            v.x = ex2(v.x);
            v.y = ex2(v.y);
            st[mi][r] = v.x;
            st[mi][r + 1] = v.y;
            ls2 = ls2 + v;
          }
        l = l * corr + (ls2.x + ls2.y);
      } else {
        float mx = -1e30f;
        const int rel = bsel ? (t - (kbase + hf * 4)) : -1;
        const int rel2 = (MODE == 2) ? rel - 511 : -1000000;
#pragma unroll
        for (int mi = 0; mi < 2; mi++)
#pragma unroll
          for (int r = 0; r < 16; r++) {
            const int cr = mi * 32 + (r >> 2) * 8 + (r & 3);
            const bool valid = (cr <= rel) && (cr >= rel2);
            float sv = valid ? st[mi][r] : -1e30f;
            st[mi][r] = sv;
            mx = fmaxf(mx, sv);
          }
        mx = fmaxf(mx, __shfl_xor(mx, 32));
        mnew = fmaxf(m, mx);
        corr = ex2(m - mnew);
        float ls = 0.f;
#pragma unroll
        for (int mi = 0; mi < 2; mi++)
#pragma unroll
          for (int r = 0; r < 16; r++) {
            float sv = st[mi][r];
            float pv = (sv > -1e29f) ? ex2(sv - mnew) : 0.f;
            st[mi][r] = pv;
            ls += pv;
          }
        l = l * corr + ls;
      }
      m = mnew;
      if (__any(corr < 1.0f)) {
#pragma unroll
        for (int di = 0; di < 2; di++)
#pragma unroll
          for (int r = 0; r < 16; r++) o[di][r] *= corr;
      }
      attn_pv(sV + half * 64, st, o, lane);
    }
  }
#undef FB_LOAD
#undef FB_STORE
  float lt = l + __shfl_xor(l, 32);
  float sc = lt > 0.f ? gate / lt : 0.f;
  add_out(outp, o, sc);
}

__device__ __forceinline__ void nsa_attn_phase(const P& p, unsigned char* smem) {
  bf16_t* sK = (bf16_t*)smem;
  bf16_t* sV = (bf16_t*)(smem + 18432);
  unsigned* sImp = (unsigned*)(smem + 35328);
  unsigned* sSel = (unsigned*)(smem + 51840);
  unsigned* sAny = (unsigned*)(smem + 52352);
  const long partsz = 8L * S_ * 64;
  const int tid = otid(), lane = tid & 63, wave = tid >> 6;
  const int qi = lane & 31, hf = lane >> 5;
#pragma unroll 1
  for (int it0 = blockIdx.x; it0 < 2048; it0 += gridDim.x) {
    const int it = item_swz(it0, 2048);
    int bg = it >> 8, qtr = it & 255;
    int qt = ((bg >> 1) & 1) ? 255 - qtr : qtr;
    int b = bg >> 2, g = bg & 3;
    int q0 = qt * 32, t = q0 + qi, hq = g * 4 + wave;
    long tg = (long)b * S_ + t;
    bf16x8 qf[4];
    {
      const bf16_t* qptr = p.Qn + tg * 1024 + hq * 64 + hf * 8;
#pragma unroll
      for (int kk = 0; kk < 4; kk++) qf[kk] = *(const bf16x8*)(qptr + kk * 16);
    }
    const float* gp = p.gate + tg * 48 + hq * 3;
    float g0 = gp[0], g1 = gp[1], g2 = gp[2];
    __syncthreads();
    for (int i = tid; i < 32 * 129; i += 256) sImp[i] = 0u;
    if (tid < 128) sSel[tid] = 0u;
    if (tid < 4) sAny[tid] = 0u;
    unsigned outp[2][8];
#pragma unroll
    for (int di = 0; di < 2; di++)
#pragma unroll
      for (int j = 0; j < 8; j++) outp[di][j] = 0u;
    {
      const bf16_t* Kg = p.Kc + (long)bg * 512 * 64;
      const bf16_t* VTg = p.VcT + (long)bg * 64 * 512;
      int nmax = 2 * qt;
      if (nmax > 510) nmax = 510;
      int ntc = (nmax >> 7) + 1;
      int nlim = (t - 31) >> 4;
      if (nlim > 510) nlim = 510;
      const int lane = otid() & 63, qi = lane & 31, hf = lane >> 5;
      float m = -1e30f, l = 0.f;
#pragma unroll 1
      for (int kt = 0; kt < ntc; kt++) {
        __syncthreads();
        stage_K(Kg + (long)kt * 128 * 64, sK);
        __syncthreads();
#pragma unroll 1
        for (int half = 0; half < 2; half++) {
          f32x16 st[2];
          attn_qk(sK + half * 64 * LSTR, qf, st, lane);
          float mx = -1e30f;
          const int rel = nlim - (kt * 128 + half * 64 + hf * 4);
#pragma unroll
          for (int mi = 0; mi < 2; mi++)
#pragma unroll
            for (int r = 0; r < 16; r++) {
              const int cr = mi * 32 + (r >> 2) * 8 + (r & 3);
              bool valid = (cr <= rel);
              float sv = valid ? st[mi][r] : -1e30f;
              st[mi][r] = sv;
              mx = fmaxf(mx, sv);
            }
          mx = fmaxf(mx, __shfl_xor(mx, 32));
          float mnew = fmaxf(m, mx);
          float ls = 0.f;
#pragma unroll
          for (int mi = 0; mi < 2; mi++)
#pragma unroll
            for (int r = 0; r < 16; r++) {
              float sv = st[mi][r];
              ls += (sv > -1e29f) ? ex2(sv - mnew) : 0.f;
            }
          l = l * ex2(m - mnew) + ls;
          m = mnew;
        }
      }
      float lt = l + __shfl_xor(l, 32);
      float inv = lt > 0.f ? 1.f / lt : 0.f;
      f32x16 o[2];
#pragma unroll
      for (int di = 0; di < 2; di++)
#pragma unroll
        for (int r = 0; r < 16; r++) o[di][r] = 0.f;
#pragma unroll 1
      for (int kt = 0; kt < ntc; kt++) {
        __syncthreads();
        stage_K(Kg + (long)kt * 128 * 64, sK);
        stage_VT(VTg + (long)kt * 128, 512, sV);
        __syncthreads();
#pragma unroll 1
        for (int half = 0; half < 2; half++) {
          f32x16 st[2];
          attn_qk(sK + half * 64 * LSTR, qf, st, lane);
          const int rel = nlim - (kt * 128 + half * 64 + hf * 4);
#pragma unroll
          for (int mi = 0; mi < 2; mi++)
#pragma unroll
            for (int rq = 0; rq < 4; rq++) {
              int nb = kt * 128 + half * 64 + mi * 32 + rq * 8 + hf * 4;
              float pv[4];
#pragma unroll
              for (int j = 0; j < 4; j++) {
                const int cr = mi * 32 + rq * 8 + j;
                bool valid = (cr <= rel);
                pv[j] = valid ? ex2(st[mi][rq * 4 + j] - m) * inv : 0.f;
                st[mi][rq * 4 + j] = pv[j];
              }
              float mainv = pv[0] + pv[1] + pv[2] + 0.5f * pv[3];
              float spill = 0.5f * pv[3];
              int j = nb >> 2;
              if (mainv > 0.f) atomicAdd(&sImp[qi * 129 + j], (unsigned)(mainv * 67108864.f + 0.5f));
              if (spill > 0.f && j + 1 < 128) atomicAdd(&sImp[qi * 129 + j + 1], (unsigned)(spill * 67108864.f + 0.5f));
            }
          attn_pv(sV + half * 64, st, o, lane);
        }
      }
      add_out(outp, o, g0);
    }
    __syncthreads();
    for (int idx = otid(); idx < 32 * 128; idx += 256) {
      int q = idx >> 7, j = idx & 127;
      int tq = q0 + q, cur = tq >> 6;
      bool avail = (j * 64 <= tq);
      bool forced = (j == 0) || (j == cur) || (j == cur - 1);
      unsigned v = sImp[q * 129 + j];
      sImp[q * 129 + j] = avail ? ((forced ? 0x80000000u : 0u) | ((v >> 6) << 8) | (unsigned)(128 - j)) : 0u;
    }
    __syncthreads();
    {
      const int tid2 = otid();
      int q = tid2 >> 3, jg = tid2 & 7;
      unsigned myk[16];
#pragma unroll
      for (int i = 0; i < 16; i++) myk[i] = sImp[q * 129 + jg + 8 * i];
      unsigned thr = 0u;
#pragma unroll 1
      for (int bit = 31; bit >= 0; bit--) {
        unsigned cand = thr | (1u << bit);
        int cnt = 0;
#pragma unroll
        for (int i = 0; i < 16; i++) cnt += (myk[i] >= cand) ? 1 : 0;
        cnt += __shfl_xor(cnt, 1);
        cnt += __shfl_xor(cnt, 2);
        cnt += __shfl_xor(cnt, 4);
        if (cnt >= 16) thr = cand;
      }
      unsigned bits[4] = {0u, 0u, 0u, 0u};
#pragma unroll
      for (int i = 0; i < 16; i++) {
        int j = jg + 8 * i;
        if (myk[i] >= thr && myk[i] != 0u) bits[i >> 2] |= 1u << (jg + 8 * (i & 3));
      }
#pragma unroll
      for (int w = 0; w < 4; w++)
        if (bits[w]) atomicOr(&sSel[q * 4 + w], bits[w]);
    }
    __syncthreads();
#pragma unroll 1
    for (int mode = 1; mode <= 2; mode++) {
      int lo = 0;
      if (mode == 2) {
        lo = q0 - 511;
        if (lo < 0) lo = 0;
        lo >>= 7;
      }
      flash_branch(mode, p.kvbuf + (long)(2 * mode) * partsz + (long)bg * S_ * 64, p.kvbuf + (long)(2 * mode + 1) * partsz + (long)bg * 64 * S_, lo,
                   (q0 + 31) >> 7, qf, t, q0, sSel + qi * 4, mode == 1 ? g1 : g2, outp, sK, sV, lane);
    }
    {
      bf16_t* dst = p.Oattn + tg * 1024 + hq * 64;
#pragma unroll
      for (int di = 0; di < 2; di++)
#pragma unroll
        for (int rq = 0; rq < 4; rq++) {
          int d = di * 32 + rq * 8 + hf * 4;
          *(uint2*)(dst + d) = make_uint2(outp[di][rq * 2], outp[di][rq * 2 + 1]);
        }
    }
  }
}


#define XB_TMO      128
#define XB_XCNT(j)  (256  + 64 * (j))
#define XB_XSUB(j)  (1280 + 64 * (j))
#define XB_XGEN(j)  (2304 + 64 * (j))
#define XB_TOP      3328
#define XB_TOPGEN   3392
#define XCD_BAR_WORDS 3456
#define XB_SPIN_CAP (1u << 22)
#define LAS __attribute__((address_space(3)))
__device__ __forceinline__ unsigned xb_ld(unsigned* p) { return __hip_atomic_load(p, __ATOMIC_RELAXED, __HIP_MEMORY_SCOPE_AGENT); }
__device__ __forceinline__ unsigned xb_add(unsigned* p, unsigned v) { return __hip_atomic_fetch_add(p, v, __ATOMIC_RELAXED, __HIP_MEMORY_SCOPE_AGENT); }
__device__ __forceinline__ unsigned xb_xcc_id() { return (unsigned)__builtin_amdgcn_s_getreg((3 << 11) | 20) & 0xFu; }
#define XB_SPIN(cond, bar) do { unsigned _sp = 0; while (cond) { __builtin_amdgcn_s_sleep(1); \
    if ((++_sp & 255u) == 0u) { if (xb_ld(&(bar)[XB_TMO])) break; if (_sp > XB_SPIN_CAP) { atomicAdd(&(bar)[XB_TMO], 1u); break; } } } } while (0)
struct XcdBarrier { unsigned* bar; unsigned x; volatile LAS unsigned* st; };
__device__ __forceinline__ XcdBarrier xcd_barrier_post(unsigned* bar, volatile LAS unsigned* st) {
  XcdBarrier b; b.bar = bar; b.x = xb_xcc_id(); b.st = st;
  if (threadIdx.x == 0) (void)xb_add(&bar[XB_XCNT(b.x)], 1u);
  return b;
}
__device__ __forceinline__ void xcd_barrier_complete(unsigned* bar, unsigned x, unsigned& nloc, unsigned& nx) {
  const unsigned G = gridDim.x * gridDim.y * gridDim.z;
  unsigned sum, cnt, mine, sp = 0u;
  for (;;) {
    sum = 0u; cnt = 0u; mine = 0u;
#pragma unroll
    for (unsigned j = 0; j < 16; ++j) { const unsigned c = xb_ld(&bar[XB_XCNT(j)]); sum += c; cnt += (c > 0u) ? 1u : 0u; mine = (j == x) ? c : mine; }
    if (sum == G) break;
    __builtin_amdgcn_s_sleep(1);
    if ((++sp & 255u) == 0u) { if (xb_ld(&bar[XB_TMO])) break; if (sp > XB_SPIN_CAP) { atomicAdd(&bar[XB_TMO], 1u); break; } }
  }
  nloc = mine > 0u ? mine : 1u; nx = cnt > 0u ? cnt : 1u;
}
__device__ __forceinline__ void xcd_barrier(const XcdBarrier& b) {
  asm volatile("s_waitcnt vmcnt(0)" ::: "memory");
  __syncthreads();
  if (threadIdx.x == 0) {
    unsigned* bar = b.bar;
    __builtin_amdgcn_s_waitcnt(0);
    unsigned nloc = b.st[0], nx = b.st[1];
    if (nloc == 0u) { xcd_barrier_complete(bar, b.x, nloc, nx); b.st[0] = nloc; b.st[1] = nx; }
    const unsigned old = xb_add(&bar[XB_XSUB(b.x)], 1u);
    const unsigned gen = old / nloc;
    if (old + 1u == (gen + 1u) * nloc) {
      __builtin_amdgcn_fence(__ATOMIC_RELEASE, "agent");
      asm volatile("s_waitcnt vmcnt(0)" ::: "memory");
      const unsigned og = xb_add(&bar[XB_TOP], 1u);
      const unsigned tg = og / nx;
      if (og + 1u == (tg + 1u) * nx) xb_add(&bar[XB_TOPGEN], 1u);
      else XB_SPIN(xb_ld(&bar[XB_TOPGEN]) == tg, bar);
      __builtin_amdgcn_fence(__ATOMIC_ACQUIRE, "agent");
      xb_add(&bar[XB_XGEN(b.x)], 1u);
      asm volatile("s_waitcnt vmcnt(0)" ::: "memory");
    } else {
      XB_SPIN(xb_ld(&bar[XB_XGEN(b.x)]) == gen, bar);
      __builtin_amdgcn_fence(__ATOMIC_ACQUIRE, "agent");
      asm volatile("s_waitcnt vmcnt(0)" ::: "memory");
    }
  }
  __syncthreads();
}

__global__ void __launch_bounds__(256, 2) mk(P p, int lo, int hi) {
  __shared__ __attribute__((aligned(16))) unsigned char smem[SMEM_BYTES];
  cg::grid_group grid = cg::this_grid();
  __shared__ uint4 xb_words;
  if (threadIdx.x == 0) xb_words = make_uint4(0u, 0u, 0u, 0u);
  __syncthreads();
  const XcdBarrier xb = xcd_barrier_post(p.bar, (volatile LAS unsigned*)&xb_words);
  int ph = 0;
#define RUN(stmt)                                   \
  {                                                 \
    if (ph >= lo && ph < hi) { stmt; }              \
    ph++;                                           \
    if (ph > lo && ph < hi) {                       \
      if (ph == 1) grid.sync(); else xcd_barrier(xb); \
    }                                               \
  }
#define RUNX(id, stmt)                                           \
  {                                                              \
    if (ph >= lo && ph < hi) { stmt; if (PROBE_ID == id) { stmt; } } \
    ph++;                                                        \
    if (ph > lo && ph < hi) {                                    \
      if (ph == 1) grid.sync(); else xcd_barrier(xb);            \
    }                                                            \
  }
  RUNX(1, prep_phase(p, smem));
  RUNX(2, h0_phase(p));
  for (int layer = 0; layer < 4; layer++) {
    if (layer < 2) {
      RUNX(3, ret_proj_phase(p, layer, smem));
      RUNX(4, ret_up_phase(p, smem));
      RUN(ret_scan_phase(p));
      RUNX(6, ret_out_phase(p, smem));
      RUN(ret_gn_phase(p));
      RUN(wo_phase(p, layer, p.Gs, p.retWoT + (long)layer * 1024 * 2048, 2048, smem));
    } else {
      if (layer == 3) { RUNX(16, nsa_q_phase(p, 1, smem)); }
      RUNX(17, nsa_attn_phase(p, smem));
      RUN(wo_phase(p, layer, p.Oattn, p.nsaWoT + (long)(layer - 2) * 1024 * 1024, 1024, smem));
    }
    RUN(ln1_phase(p, layer));
    RUNX(10, peer_qscore_phase(p, layer, smem));
    {
      if (PROBE_ID == 12 && ph >= lo && ph < hi) peer_expert_phase(p, layer, smem, true);
      RUN(peer_expert_phase(p, layer, smem, false));
    }
    if (layer == 1) {
      RUNX(13, kv_proj_phase(p, smem));
      RUN({ cmp1_phase(p, smem); nsa_q_phase(p, 0, smem); });
      RUNX(15, cmp2_phase(p, smem));
    }
  }
}
#define NPHASES (2 + 2 * 6 + 5 + 4 * 3 + 3)

extern "C" void kernel_launch(void* const* d_in, const int* in_sizes, int n_in, void* d_out, int out_size, void* d_ws,
                              size_t ws_size, hipStream_t stream) {
  static int grid_blocks = 0;
  if (!grid_blocks) {
    int dev = 0, cus = 0, per_cu = 0;
    hipGetDevice(&dev);
    hipDeviceGetAttribute(&cus, hipDeviceAttributeMultiprocessorCount, dev);
    hipOccupancyMaxActiveBlocksPerMultiprocessor(&per_cu, mk, 256, 0);
    if (per_cu > 2) per_cu = 2;
    if (per_cu < 1) per_cu = 1;
    grid_blocks = cus * per_cu;
  }
  P p{};
  const float** fin = (const float**)&p;
  for (int i = 0; i < 21; i++) fin[i] = (const float*)d_in[i];
  p.out = (float*)d_out;
  size_t off = 0;
  auto alloc = [&](size_t bytes) {
    void* r = (char*)d_ws + off;
    off += (bytes + 255) & ~(size_t)255;
    return r;
  };
  p.retWinT = (bf16_t*)alloc(2UL * 6144 * 1024 * 2);
  p.retWoT = (bf16_t*)alloc(2UL * 1024 * 2048 * 2);
  p.kvWT = (bf16_t*)alloc(1536UL * 1024 * 2);
  p.w1T = (bf16_t*)alloc(2UL * 256 * 2048 * 2);
  p.w2T = (bf16_t*)alloc(2UL * 128 * 256 * 2);
  p.nsaWinT = (bf16_t*)alloc(2UL * 1152 * 1024 * 2);
  p.nsaWoT = (bf16_t*)alloc(2UL * 1024 * 1024 * 2);
  p.wqT = (bf16_t*)alloc(4UL * 2048 * 1024 * 2);
  p.keysB = (bf16_t*)alloc(4UL * 16 * 128 * 128 * 2);
  p.uB = (unsigned char*)alloc(4UL * 16384 * 2048);
  p.vB = p.uB + 1024;
  p.su = (float*)alloc(4UL * 16384 * 4);
  p.sv = (float*)alloc(4UL * 16384 * 4);
  p.mods = (float*)alloc(4UL * 2 * 6144 * 4);
  p.kvmod = (float*)alloc(2UL * 2048 * 4);
  p.cs = (float*)alloc(8192UL * 128 * 2 * 4);
  p.biasp = (float*)alloc(512 * 4);
  p.bar = (unsigned*)alloc(XCD_BAR_WORDS * 4);
  p.xbuf = (float*)alloc((size_t)T_ * 1024 * 4);
  p.hbuf = (bf16_t*)alloc((size_t)T_ * 1024 * 2);
  p.xsbuf = (bf16_t*)alloc((size_t)T_ * 1024 * 2);
  p.kvbuf = (bf16_t*)alloc(6UL * 8 * S_ * 64 * 2 + 65536);
  p.Kc = (bf16_t*)alloc(8UL * 512 * 64 * 2);
  p.VcT = (bf16_t*)alloc(8UL * 64 * 512 * 2);
  size_t arena = off;
  p.Qd = (bf16_t*)alloc(8UL * S_ * 256 * 2);
  p.Kd = (bf16_t*)alloc(8UL * S_ * 256 * 2);
  p.KdT = (bf16_t*)alloc(8UL * 256 * S_ * 2);
  p.VT = (bf16_t*)alloc(8UL * 512 * S_ * 2);
  p.Gs = (bf16_t*)alloc((size_t)T_ * 2048 * 2);
  p.ST = (bf16_t*)alloc(8UL * 64 * 512 * 256 * 2);
  p.Pb = (bf16_t*)alloc(8UL * 64 * 128 * 128 * 2);
  p.Ob = (bf16_t*)alloc((size_t)T_ * 2048 * 2);
  size_t end_ret = off;
  off = arena;
  p.qp = (bf16_t*)alloc((size_t)T_ * 2048 * 2);
  p.topk = (int*)alloc((size_t)T_ * 16 * 16 * 4);
  p.Qn = (bf16_t*)alloc((size_t)T_ * 1024 * 2);
  p.gate = (float*)alloc((size_t)T_ * 48 * 4);
  p.Oattn = (bf16_t*)alloc((size_t)T_ * 1024 * 2);
  p.hid = (bf16_t*)alloc(16UL * 512 * 256 * 2);
  size_t end_other = off;
  size_t need = end_ret > end_other ? end_ret : end_other;
  if (need > ws_size) {
    fprintf(stderr, "workspace too small: need %zu have %zu\n", need, ws_size);
    return;
  }
#if MULTI_LAUNCH
  for (int ph = 0; ph < NPHASES; ph++) {
    hipLaunchKernelGGL(mk, dim3(grid_blocks), dim3(256), 0, stream, p, ph, ph + 1);
  }
#else
  hipMemsetAsync(p.bar, 0, XCD_BAR_WORDS * 4, stream);
  int lo = 0, hi = NPHASES;
  void* args[] = {&p, &lo, &hi};
  hipError_t e = hipLaunchCooperativeKernel((void*)mk, dim3(grid_blocks), dim3(256), args, 0, stream);
  if (e != hipSuccess) fprintf(stderr, "cooperative launch failed: %s (grid %d)\n", hipGetErrorString(e), grid_blocks);
#endif
}
```

```cpp
#include <hip/hip_runtime.h>
#include <hip/hip_cooperative_groups.h>
#include <cstdio>
#include <cstdint>
namespace cg = cooperative_groups;

typedef unsigned short bf16_t;
typedef short bf16x8 __attribute__((ext_vector_type(8)));
typedef float f32x16 __attribute__((ext_vector_type(16)));
typedef float f32x2 __attribute__((ext_vector_type(2)));

#ifndef PROBE_ID
#define PROBE_ID 0
#endif
#ifndef MULTI_LAUNCH
#define MULTI_LAUNCH 0
#endif

#define T_ 16384
#define S_ 8192
#define D_ 1024
#define ALPHA_ 1.681792830507429f
#define LN_EPS_ 1e-5f
#define SMEM_BYTES 73728
#define LSTR 72

struct P {
  const float *x, *c, *ada_w, *ada_b, *ln_g, *ln_b, *ret_w_in, *ret_w_o, *kv_ada_w, *kv_ada_b, *nsa_w_kv,
      *cmp_pe, *cmp_w1, *cmp_b1, *cmp_w2, *nsa_w_in, *nsa_w_o, *peer_w_q, *peer_keys, *peer_u, *peer_v;
  float* out;
  bf16_t *retWinT, *retWoT, *kvWT, *w1T, *w2T, *nsaWinT, *nsaWoT, *wqT, *keysB;
  unsigned char *uB, *vB;
  float *su, *sv;
  float *mods, *kvmod, *cs, *biasp;
  float* xbuf;
  bf16_t *hbuf, *xsbuf;
  bf16_t *kvbuf, *hid, *Kc, *VcT;
  bf16_t *Qd, *Kd, *KdT, *VT, *Gs, *ST, *Pb, *Ob;
  bf16_t* qp;
  int* topk;
  bf16_t* Qn;
  float* gate;
  bf16_t* Oattn;
  unsigned* bar;
};

__device__ __forceinline__ int otid() {
  int t = threadIdx.x;
  asm volatile("" : "+v"(t));
  return t;
}
__device__ __forceinline__ float bf2f(bf16_t b) { return __uint_as_float(((unsigned)b) << 16); }
__device__ __forceinline__ bf16_t f2bf(float f) {
  unsigned u = __float_as_uint(f);
  u += 0x7fffu + ((u >> 16) & 1u);
  return (bf16_t)(u >> 16);
}
typedef __bf16 bf16x2_t __attribute__((ext_vector_type(2)));
__device__ __forceinline__ unsigned pack2(float a, float b) {
  f32x2 v = {a, b};
  bf16x2_t r = __builtin_convertvector(v, bf16x2_t);
  return __builtin_bit_cast(unsigned, r);
}
__device__ __forceinline__ float ex2(float x) { return __builtin_amdgcn_exp2f(x); }
__device__ __forceinline__ float gelu_t(float x) {
  float u = 0.7978845608028654f * (x + 0.044715f * x * x * x);
  return x / (1.f + __expf(-2.f * u));
}
__device__ __forceinline__ float silu_f(float x) { return x / (1.f + __expf(-x)); }
__device__ __forceinline__ float sigmoid_f(float x) { return 1.f / (1.f + __expf(-x)); }
__device__ __forceinline__ float wave_allsum(float v) {
#pragma unroll
  for (int o = 32; o >= 1; o >>= 1) v += __shfl_xor(v, o);
  return v;
}
__device__ __forceinline__ f32x16 mfma32(bf16x8 a, bf16x8 b, f32x16 c) {
  return __builtin_amdgcn_mfma_f32_32x32x16_bf16(a, b, c, 0, 0, 0);
}

__device__ __forceinline__ void gemm_tile(const bf16_t* __restrict__ A, long lda, const bf16_t* __restrict__ B, long ldb,
                                          int K, f32x16 (&acc)[2][2], unsigned char* smem) {
  const int tid = otid(), lane = tid & 63, wave = tid >> 6;
  const int wm = wave >> 1, wn = wave & 1;
  const int lr = tid >> 3, lc = (tid & 7) * 8;
  bf16_t* sA = (bf16_t*)smem;
  bf16_t* sB = sA + 2 * 128 * LSTR;
  const bf16_t* Ap = A + (long)lr * lda + lc;
  const bf16_t* Bp = B + (long)lr * ldb + lc;
  uint4 ra0_0, ra0_1, ra0_2, ra0_3, rb0_0, rb0_1, rb0_2, rb0_3, ra1_0, ra1_1, ra1_2, ra1_3, rb1_0, rb1_1, rb1_2, rb1_3;
  const int nk = K >> 6;
#define G_LOAD1(RA, RB, KT, i)                                        \
  RA##_##i = *(const uint4*)(Ap + (long)(i * 32) * lda + (KT) * 64);       \
  RB##_##i = *(const uint4*)(Bp + (long)(i * 32) * ldb + (KT) * 64);
#define G_LOAD(RA, RB, KT) G_LOAD1(RA, RB, KT, 0) G_LOAD1(RA, RB, KT, 1) G_LOAD1(RA, RB, KT, 2) G_LOAD1(RA, RB, KT, 3)
#define G_STORE1(RA, RB, BUF, i)                                                  \
  *(uint4*)(sA + (BUF) * 128 * LSTR + (lr + i * 32) * LSTR + lc) = RA##_##i;         \
  *(uint4*)(sB + (BUF) * 128 * LSTR + (lr + i * 32) * LSTR + lc) = RB##_##i;
#define G_STORE(RA, RB, BUF) G_STORE1(RA, RB, BUF, 0) G_STORE1(RA, RB, BUF, 1) G_STORE1(RA, RB, BUF, 2) G_STORE1(RA, RB, BUF, 3)
#define G_CK(BUF, kk)                                                                                       \
  {                                                                                                         \
    bf16x8 a0 = *(const bf16x8*)(a_s + (BUF) * 128 * LSTR + kk * 16);                                       \
    bf16x8 a1 = *(const bf16x8*)(a_s + (BUF) * 128 * LSTR + 32 * LSTR + kk * 16);                           \
    bf16x8 b0 = *(const bf16x8*)(b_s + (BUF) * 128 * LSTR + kk * 16);                                       \
    bf16x8 b1 = *(const bf16x8*)(b_s + (BUF) * 128 * LSTR + 64 * LSTR + kk * 16);                           \
    acc[0][0] = mfma32(a0, b0, acc[0][0]);                                                                  \
    acc[0][1] = mfma32(a0, b1, acc[0][1]);                                                                  \
    acc[1][0] = mfma32(a1, b0, acc[1][0]);                                                                  \
    acc[1][1] = mfma32(a1, b1, acc[1][1]);                                                                  \
  }
#define G_COMPUTE(BUF) G_CK(BUF, 0) G_CK(BUF, 1) G_CK(BUF, 2) G_CK(BUF, 3)
  const bf16_t* a_s = sA + (wm * 64 + (lane & 31)) * LSTR + (lane >> 5) * 8;
  const bf16_t* b_s = sB + (wn * 32 + (lane & 31)) * LSTR + (lane >> 5) * 8;
  __syncthreads();
  G_LOAD(ra0, rb0, 0);
  G_LOAD(ra1, rb1, 1);
  G_STORE(ra0, rb0, 0);
  __syncthreads();
#pragma unroll 1
  for (int kt = 0; kt < nk; kt += 2) {
    if (kt + 2 < nk) { G_LOAD(ra0, rb0, kt + 2); }
    G_COMPUTE(0);
    G_STORE(ra1, rb1, 1);
    __syncthreads();
    if (kt + 3 < nk) { G_LOAD(ra1, rb1, kt + 3); }
    G_COMPUTE(1);
    if (kt + 2 < nk) { G_STORE(ra0, rb0, 0); }
    __syncthreads();
  }
#undef G_LOAD
#undef G_LOAD1
#undef G_STORE
#undef G_STORE1
#undef G_COMPUTE
#undef G_CK
}

__device__ __forceinline__ void gemm_tile_w41(const bf16_t* __restrict__ A, long lda, const bf16_t* __restrict__ B, long ldb,
                                              int K, f32x16 (&acc)[4], unsigned char* smem) {
  const int tid = otid(), lane = tid & 63, wave = tid >> 6;
  const int lr = tid >> 3, lc = (tid & 7) * 8;
  bf16_t* sA = (bf16_t*)smem;
  bf16_t* sB = sA + 2 * 128 * LSTR;
  const bf16_t* Ap = A + (long)lr * lda + lc;
  const bf16_t* Bp = B + (long)lr * ldb + lc;
  uint4 ra0_0, ra0_1, ra0_2, ra0_3, rb0_0, rb0_1, rb0_2, rb0_3, ra1_0, ra1_1, ra1_2, ra1_3, rb1_0, rb1_1, rb1_2, rb1_3;
  const int nk = K >> 6;
#define G_LOAD1(RA, RB, KT, i)                                        \
  RA##_##i = *(const uint4*)(Ap + (long)(i * 32) * lda + (KT) * 64);  \
  RB##_##i = *(const uint4*)(Bp + (long)(i * 32) * ldb + (KT) * 64);
#define G_LOAD(RA, RB, KT) G_LOAD1(RA, RB, KT, 0) G_LOAD1(RA, RB, KT, 1) G_LOAD1(RA, RB, KT, 2) G_LOAD1(RA, RB, KT, 3)
#define G_STORE1(RA, RB, BUF, i)                                                  \
  *(uint4*)(sA + (BUF) * 128 * LSTR + (lr + i * 32) * LSTR + lc) = RA##_##i;      \
  *(uint4*)(sB + (BUF) * 128 * LSTR + (lr + i * 32) * LSTR + lc) = RB##_##i;
#define G_STORE(RA, RB, BUF) G_STORE1(RA, RB, BUF, 0) G_STORE1(RA, RB, BUF, 1) G_STORE1(RA, RB, BUF, 2) G_STORE1(RA, RB, BUF, 3)
#define G_CK(BUF, kk)                                                                         \
  {                                                                                           \
    bf16x8 b0 = *(const bf16x8*)(b_s + (BUF) * 128 * LSTR + kk * 16);                         \
    bf16x8 a0 = *(const bf16x8*)(a_s + (BUF) * 128 * LSTR + kk * 16);                         \
    bf16x8 a1 = *(const bf16x8*)(a_s + (BUF) * 128 * LSTR + 32 * LSTR + kk * 16);             \
    bf16x8 a2 = *(const bf16x8*)(a_s + (BUF) * 128 * LSTR + 64 * LSTR + kk * 16);             \
    bf16x8 a3 = *(const bf16x8*)(a_s + (BUF) * 128 * LSTR + 96 * LSTR + kk * 16);             \
    acc[0] = mfma32(a0, b0, acc[0]);                                                          \
    acc[1] = mfma32(a1, b0, acc[1]);                                                          \
    acc[2] = mfma32(a2, b0, acc[2]);                                                          \
    acc[3] = mfma32(a3, b0, acc[3]);                                                          \
  }
#define G_COMPUTE(BUF) G_CK(BUF, 0) G_CK(BUF, 1) G_CK(BUF, 2) G_CK(BUF, 3)
  const bf16_t* a_s = sA + (lane & 31) * LSTR + (lane >> 5) * 8;
  const bf16_t* b_s = sB + (wave * 32 + (lane & 31)) * LSTR + (lane >> 5) * 8;
  __syncthreads();
  G_LOAD(ra0, rb0, 0);
  G_LOAD(ra1, rb1, 1);
  G_STORE(ra0, rb0, 0);
  __syncthreads();
#pragma unroll 1
  for (int kt = 0; kt < nk; kt += 2) {
    if (kt + 2 < nk) { G_LOAD(ra0, rb0, kt + 2); }
    G_COMPUTE(0);
    G_STORE(ra1, rb1, 1);
    __syncthreads();
    if (kt + 3 < nk) { G_LOAD(ra1, rb1, kt + 3); }
    G_COMPUTE(1);
    if (kt + 2 < nk) { G_STORE(ra0, rb0, 0); }
    __syncthreads();
  }
#undef G_LOAD
#undef G_LOAD1
#undef G_STORE
#undef G_STORE1
#undef G_COMPUTE
#undef G_CK
}

__device__ __forceinline__ void gemm_tile256(const bf16_t* __restrict__ A, long lda, const bf16_t* __restrict__ B, long ldb,
                                             int K, f32x16 (&acc)[2][4], unsigned char* smem) {
  const int tid = otid(), lane = tid & 63, wave = tid >> 6;
  const int lr = tid >> 3, lc = (tid & 7) * 8;
  bf16_t* sA = (bf16_t*)smem;
  bf16_t* sB = sA + 256 * LSTR;
  const bf16_t* Ap = A + (long)lr * lda + lc;
  const bf16_t* Bp = B + (long)lr * ldb + lc;
  uint4 a_0, a_1, a_2, a_3, a_4, a_5, a_6, a_7, b_0, b_1, b_2, b_3;
  const int nk = K >> 6;
#define H_LA(i, KT) a_##i = *(const uint4*)(Ap + (long)(i * 32) * lda + (KT) * 64);
#define H_LB(i, KT) b_##i = *(const uint4*)(Bp + (long)(i * 32) * ldb + (KT) * 64);
#define H_LOAD(KT) H_LA(0, KT) H_LA(1, KT) H_LA(2, KT) H_LA(3, KT) H_LA(4, KT) H_LA(5, KT) H_LA(6, KT) H_LA(7, KT) H_LB(0, KT) H_LB(1, KT) H_LB(2, KT) H_LB(3, KT)
#define H_SA(i) *(uint4*)(sA + (lr + i * 32) * LSTR + lc) = a_##i;
#define H_SB(i) *(uint4*)(sB + (lr + i * 32) * LSTR + lc) = b_##i;
#define H_STORE() H_SA(0) H_SA(1) H_SA(2) H_SA(3) H_SA(4) H_SA(5) H_SA(6) H_SA(7) H_SB(0) H_SB(1) H_SB(2) H_SB(3)
  const bf16_t* a_s = sA + (wave * 64 + (lane & 31)) * LSTR + (lane >> 5) * 8;
  const bf16_t* b_s = sB + (lane & 31) * LSTR + (lane >> 5) * 8;
  H_LOAD(0);
#pragma unroll 1
  for (int kt = 0; kt < nk; kt++) {
    __syncthreads();
    H_STORE();
    __syncthreads();
    const int kn = (kt + 1 < nk) ? kt + 1 : kt;
    H_LOAD(kn);
    __builtin_amdgcn_sched_barrier(0);
#pragma unroll
    for (int kk = 0; kk < 4; kk++) {
      bf16x8 fa0 = *(const bf16x8*)(a_s + kk * 16);
      bf16x8 fa1 = *(const bf16x8*)(a_s + 32 * LSTR + kk * 16);
      bf16x8 fb0 = *(const bf16x8*)(b_s + kk * 16);
      bf16x8 fb1 = *(const bf16x8*)(b_s + 32 * LSTR + kk * 16);
      bf16x8 fb2 = *(const bf16x8*)(b_s + 64 * LSTR + kk * 16);
      bf16x8 fb3 = *(const bf16x8*)(b_s + 96 * LSTR + kk * 16);
      acc[0][0] = mfma32(fa0, fb0, acc[0][0]);
      acc[0][1] = mfma32(fa0, fb1, acc[0][1]);
      acc[0][2] = mfma32(fa0, fb2, acc[0][2]);
      acc[0][3] = mfma32(fa0, fb3, acc[0][3]);
      acc[1][0] = mfma32(fa1, fb0, acc[1][0]);
      acc[1][1] = mfma32(fa1, fb1, acc[1][1]);
      acc[1][2] = mfma32(fa1, fb2, acc[1][2]);
      acc[1][3] = mfma32(fa1, fb3, acc[1][3]);
    }
  }
  __syncthreads();
#undef H_LA
#undef H_LB
#undef H_LOAD
#undef H_SA
#undef H_SB
#undef H_STORE
}
template <class F>
__device__ __forceinline__ void epi_pairs256(const f32x16 (&acc)[2][4], F f) {
  const int tid_ = otid();
  const int lane = tid_ & 63, wave = tid_ >> 6;
#pragma unroll
  for (int mi = 0; mi < 2; mi++)
#pragma unroll
    for (int np = 0; np < 2; np++)
#pragma unroll
      for (int rq = 0; rq < 4; rq++) {
        int row0 = wave * 64 + mi * 32 + rq * 8 + (lane >> 5) * 4;
        int col0 = np * 32 + (lane & 31);
        float v0[4], v1[4];
#pragma unroll
        for (int j = 0; j < 4; j++) {
          v0[j] = acc[mi][np][rq * 4 + j];
          v1[j] = acc[mi][np + 2][rq * 4 + j];
        }
        f(row0, col0, v0, v1);
      }
}

__device__ __forceinline__ void tile_map(int it, int ntm, int ntn, int mode, int& tm, int& tn) {
  const int G = gridDim.x, total = ntm * ntn;
  const int r = it / G, b = it - r * G;
  int t2 = it;
  if ((G & 63) == 0 && (r + 1) * G <= total) {
    const int xcd = b & 7, j = b >> 3, cpx = G >> 3;
    if (mode == 1) {
      t2 = r * G + xcd * cpx + j;
    } else if (mode == 2 && cpx == 64 && (ntn & 7) == 0 && (ntm & 7) == 0) {
      const int q = r * 8 + xcd, npn = ntn >> 3;
      const int qm = q / npn, qn = q - qm * npn;
      tm = qm * 8 + (j >> 3);
      tn = qn * 8 + (j & 7);
      return;
    }
  }
  tn = t2 % ntn;
  tm = t2 / ntn;
}

__device__ __forceinline__ int item_swz(int it, int total) {
  const int G = gridDim.x;
  const int r = it / G, b = it - r * G;
  if ((G & 7) == 0 && (r + 1) * G <= total) return r * G + (b & 7) * (G >> 3) + (b >> 3);
  return it;
}
__device__ __forceinline__ void zero_acc(f32x16 (&acc)[2][2]) {
#pragma unroll
  for (int i = 0; i < 2; i++)
#pragma unroll
    for (int j = 0; j < 2; j++)
#pragma unroll
      for (int r = 0; r < 16; r++) acc[i][j][r] = 0.f;
}

template <class F>
__device__ __forceinline__ void epi_pairs(const f32x16 (&acc)[2][2], F f) {
  const int tid_ = otid(); const int lane = tid_ & 63, wave = tid_ >> 6, wm = wave >> 1, wn = wave & 1;
#pragma unroll
  for (int mi = 0; mi < 2; mi++)
#pragma unroll
    for (int rq = 0; rq < 4; rq++) {
      int row0 = wm * 64 + mi * 32 + rq * 8 + (lane >> 5) * 4;
      int col0 = wn * 32 + (lane & 31);
      float v0[4], v1[4];
#pragma unroll
      for (int j = 0; j < 4; j++) {
        v0[j] = acc[mi][0][rq * 4 + j];
        v1[j] = acc[mi][1][rq * 4 + j];
      }
      f(row0, col0, v0, v1);
    }
}

__device__ __forceinline__ void transpose_job(const float* __restrict__ src, int K, int N, bf16_t* __restrict__ dst, int Npad, int perm,
                              unsigned char* smem) {
  float* t = (float*)smem;
  const int tid = otid();
  const int tilesN = Npad / 64, tilesK = K / 64;
  for (int it = blockIdx.x; it < tilesN * tilesK; it += gridDim.x) {
    int tn = it % tilesN, tk = it / tilesN;
    int n0 = tn * 64, k0 = tk * 64;
    int sn0 = n0;
    if (perm && n0 < 2048) {
      int hd = n0 >> 8, t2 = (n0 >> 7) & 1, half = (n0 >> 6) & 1;
      sn0 = hd * 256 + half * 128 + t2 * 64;
    }
    __syncthreads();
    {
      int kk = tid >> 2;
#pragma unroll
      for (int j = 0; j < 4; j++) {
        int cc = (tid & 3) * 16 + j * 4;
        float4 v = make_float4(0.f, 0.f, 0.f, 0.f);
        if (sn0 + cc < N) v = *(const float4*)(src + (long)(k0 + kk) * N + sn0 + cc);
        t[(cc + 0) * 65 + kk] = v.x;
        t[(cc + 1) * 65 + kk] = v.y;
        t[(cc + 2) * 65 + kk] = v.z;
        t[(cc + 3) * 65 + kk] = v.w;
      }
    }
    __syncthreads();
    {
      int n = tid >> 2, kc = (tid & 3) * 16;
      unsigned w[8];
#pragma unroll
      for (int j = 0; j < 8; j++) w[j] = pack2(t[n * 65 + kc + 2 * j], t[n * 65 + kc + 2 * j + 1]);
      uint4* d = (uint4*)(dst + (long)(n0 + n) * K + k0 + kc);
      d[0] = make_uint4(w[0], w[1], w[2], w[3]);
      d[1] = make_uint4(w[4], w[5], w[6], w[7]);
    }
  }
}

__device__ __forceinline__ void convert_job(const float* __restrict__ src, bf16_t* __restrict__ dst, long n) {
  long i = ((long)blockIdx.x * 256 + otid()) * 8;
  long stride = (long)gridDim.x * 256 * 8;
  for (; i < n; i += stride) {
    float4 a = *(const float4*)(src + i), b = *(const float4*)(src + i + 4);
    *(uint4*)(dst + i) = make_uint4(pack2(a.x, a.y), pack2(a.z, a.w), pack2(b.x, b.y), pack2(b.z, b.w));
  }
}


__device__ __forceinline__ float dpp_rowsum(float v) {
  v += __int_as_float(__builtin_amdgcn_update_dpp(0, __float_as_int(v), 0xB1, 0xF, 0xF, true));
  v += __int_as_float(__builtin_amdgcn_update_dpp(0, __float_as_int(v), 0x4E, 0xF, 0xF, true));
  v += __int_as_float(__builtin_amdgcn_update_dpp(0, __float_as_int(v), 0x141, 0xF, 0xF, true));
  v += __int_as_float(__builtin_amdgcn_update_dpp(0, __float_as_int(v), 0x140, 0xF, 0xF, true));
  return v;
}
__device__ __forceinline__ float wave_allsum_fast(float v) {
  v = dpp_rowsum(v);
  float s0 = __int_as_float(__builtin_amdgcn_readlane(__float_as_int(v), 0));
  float s1 = __int_as_float(__builtin_amdgcn_readlane(__float_as_int(v), 16));
  float s2 = __int_as_float(__builtin_amdgcn_readlane(__float_as_int(v), 32));
  float s3 = __int_as_float(__builtin_amdgcn_readlane(__float_as_int(v), 48));
  return (s0 + s1) + (s2 + s3);
}
__device__ __forceinline__ void convert_fp8_job(const float* __restrict__ src, unsigned char* __restrict__ dst, float* __restrict__ inv_scale, int rows) {
  const int tid = otid(), lane = tid & 63, wave = tid >> 6;
  for (int r = blockIdx.x * 4 + wave; r < rows; r += gridDim.x * 4) {
    const float* sr = src + (long)r * 1024;
    float v[16];
#pragma unroll
    for (int j = 0; j < 2; j++) {
      float4 a = *(const float4*)(sr + j * 512 + lane * 8), b = *(const float4*)(sr + j * 512 + lane * 8 + 4);
      v[j * 8 + 0] = a.x; v[j * 8 + 1] = a.y; v[j * 8 + 2] = a.z; v[j * 8 + 3] = a.w;
      v[j * 8 + 4] = b.x; v[j * 8 + 5] = b.y; v[j * 8 + 6] = b.z; v[j * 8 + 7] = b.w;
    }
    float mx = 0.f;
#pragma unroll
    for (int i = 0; i < 16; i++) mx = fmaxf(mx, fabsf(v[i]));
#pragma unroll
    for (int o = 32; o >= 1; o >>= 1) mx = fmaxf(mx, __shfl_xor(mx, o));
    mx = fmaxf(mx, 1e-20f);
    float sc = 384.f / mx;
    int w[4];
#pragma unroll
    for (int q = 0; q < 4; q++) {
      int x = 0;
      x = __builtin_amdgcn_cvt_pk_fp8_f32(v[q * 4 + 0] * sc, v[q * 4 + 1] * sc, x, false);
      x = __builtin_amdgcn_cvt_pk_fp8_f32(v[q * 4 + 2] * sc, v[q * 4 + 3] * sc, x, true);
      w[q] = x;
    }
    *(int4*)(dst + (long)r * 2048 + lane * 16) = make_int4(w[0], w[1], w[2], w[3]);
    if (lane == 0) inv_scale[r] = mx * (1.f / 384.f);
  }
}

__device__ __forceinline__ void modvec_job(const float* __restrict__ c, const float* __restrict__ W, const float* __restrict__ bias,
                           float* __restrict__ out, int N, int item0, int nitems_total_before, unsigned char* smem) {
}

__device__ __forceinline__ void prep_phase(const P& p, unsigned char* smem) {
  for (int l = 0; l < 2; l++) {
    transpose_job(p.ret_w_in + (long)l * 1024 * 6144, 1024, 6144, p.retWinT + (long)l * 6144 * 1024, 6144, 1, smem);
    transpose_job(p.ret_w_o + (long)l * 2048 * 1024, 2048, 1024, p.retWoT + (long)l * 1024 * 2048, 1024, 0, smem);
    transpose_job(p.cmp_w1 + (long)l * 2048 * 256, 2048, 256, p.w1T + (long)l * 256 * 2048, 256, 0, smem);
    transpose_job(p.cmp_w2 + (long)l * 256 * 64, 256, 64, p.w2T + (long)l * 128 * 256, 128, 0, smem);
    transpose_job(p.nsa_w_in + (long)l * 1024 * 1072, 1024, 1072, p.nsaWinT + (long)l * 1152 * 1024, 1152, 0, smem);
    transpose_job(p.nsa_w_o + (long)l * 1024 * 1024, 1024, 1024, p.nsaWoT + (long)l * 1024 * 1024, 1024, 0, smem);
  }
  transpose_job(p.nsa_w_kv, 1024, 1536, p.kvWT, 1536, 0, smem);
  for (int l = 0; l < 4; l++)
    transpose_job(p.peer_w_q + (long)l * 1024 * 2048, 1024, 2048, p.wqT + (long)l * 2048 * 1024, 2048, 0, smem);
  convert_job(p.peer_keys, p.keysB, 4L * 8 * 2 * 128 * 128);
  convert_fp8_job(p.peer_u, p.uB, p.su, 4 * 16384);
  convert_fp8_job(p.peer_v, p.uB + 1024, p.sv, 4 * 16384);
  {
    __syncthreads();
    float* red = (float*)smem;
    float* sc_ = (float*)smem + 512;
    const int tid = otid(), lane = tid & 63, wave = tid >> 6;
    for (int i = tid; i < 2048; i += 256) sc_[i] = silu_f(p.c[i]);
    __syncthreads();
    const int nitems = (4 * 6144 + 2048) / 64;
    for (int it = blockIdx.x; it < nitems; it += gridDim.x) {
      int col = it * 64 + lane;
      const float* W;
      const float* bias;
      float* out;
      int N, n;
      if (col < 4 * 6144) {
        int l = col / 6144;
        n = col % 6144;
        W = p.ada_w + (long)l * 1024 * 6144;
        bias = p.ada_b + l * 6144;
        out = p.mods + l * 2 * 6144;
        N = 6144;
      } else {
        n = col - 4 * 6144;
        W = p.kv_ada_w;
        bias = p.kv_ada_b;
        out = p.kvmod;
        N = 2048;
      }
      float a0 = 0.f, a1 = 0.f;
      const float* wp = W + (long)(wave * 256) * N + n;
      const float* c0 = sc_ + wave * 256;
      for (int k = 0; k < 256; k += 16) {
        float w[16];
#pragma unroll
        for (int u = 0; u < 16; u++) w[u] = wp[(long)(k + u) * N];
#pragma unroll
        for (int u = 0; u < 16; u++) {
          a0 += c0[k + u] * w[u];
          a1 += c0[1024 + k + u] * w[u];
        }
      }
      __syncthreads();
      red[(wave * 2 + 0) * 64 + lane] = a0;
      red[(wave * 2 + 1) * 64 + lane] = a1;
      __syncthreads();
      if (wave < 2) {
        float sm = bias[n];
        for (int w = 0; w < 4; w++) sm += red[(w * 2 + wave) * 64 + lane];
        out[wave * N + n] = sm;
      }
    }
  }
  {
    long n = 8192L * 128;
    for (long i = (long)blockIdx.x * 256 + otid(); i < n; i += (long)gridDim.x * 256) {
      int s = (int)(i >> 7), fi = (int)(i & 127);
      float theta = 1.0f / powf(10000.0f, (float)fi / 127.0f);
      float ang = (float)s * theta;
      float sn, cn;
      sincosf(ang, &sn, &cn);
      p.cs[2 * i] = cn;
      p.cs[2 * i + 1] = sn;
    }
  }
  {
    const int tid = otid(), lane = tid & 63, wave = tid >> 6;
    for (int o = blockIdx.x * 4 + wave; o < 512; o += gridDim.x * 4) {
      int c = o >> 8, j = o & 255;
      float sm = 0.f;
      for (int f = lane; f < 2048; f += 64) sm += p.cmp_pe[c * 2048 + f] * p.cmp_w1[((long)c * 2048 + f) * 256 + j];
      sm = wave_allsum(sm);
      if (lane == 0) p.biasp[o] = sm + p.cmp_b1[c * 256 + j];
    }
  }
}

__device__ __forceinline__ void h0_phase(const P& p) {
  long n = (long)T_ * D_;
  for (long i = ((long)blockIdx.x * 256 + otid()) * 8; i < n; i += (long)gridDim.x * 256 * 8) {
    int t = (int)(i >> 10), k = (int)(i & 1023);
    int b = t / S_;
    const float* md = p.mods + b * 6144;
    float4 a = *(const float4*)(p.x + i), bb = *(const float4*)(p.x + i + 4);
    float xv[8] = {a.x, a.y, a.z, a.w, bb.x, bb.y, bb.z, bb.w};
    float h[8];
#pragma unroll
    for (int j = 0; j < 8; j++) h[j] = xv[j] * (1.f + md[1024 + k + j]) + md[k + j];
    *(uint4*)(p.hbuf + i) = make_uint4(pack2(h[0], h[1]), pack2(h[2], h[3]), pack2(h[4], h[5]), pack2(h[6], h[7]));
  }
}

__device__ __forceinline__ void ret_proj_phase(const P& p, int layer, unsigned char* smem) {
  const bf16_t* W = p.retWinT + (long)layer * 6144 * 1024;
  const int ntn = 48, ntm = 64;
  for (int it = blockIdx.x; it < ntn * ntm; it += gridDim.x) {
    int tn = it % ntn, tm = it / ntn;
    f32x16 acc[2][4];
#pragma unroll
    for (int i = 0; i < 2; i++)
#pragma unroll
      for (int j = 0; j < 4; j++)
#pragma unroll
        for (int r = 0; r < 16; r++) acc[i][j][r] = 0.f;
    gemm_tile256(p.hbuf + (long)tm * 256 * 1024, 1024, W + (long)tn * 128 * 1024, 1024, 1024, acc, smem);
    const int m0 = tm * 256;
    const int b = m0 / S_, s0 = m0 % S_;
    if (tn < 16) {
      const bool isK = tn >= 8;
      const int hd = (tn & 7) >> 1, t2 = tn & 1;
      const float lg = log1pf(-exp2f(-5.0f - (float)hd));
      const long bh = b * 4 + hd;
      epi_pairs256(acc, [&](int row0, int col0, const float* v0, const float* v1) {
        int fi = t2 * 64 + col0;
        float o1[4], o2[4];
#pragma unroll
        for (int j = 0; j < 4; j++) {
          int s = s0 + row0 + j;
          float2 cs = *(const float2*)(p.cs + 2 * ((long)s * 128 + fi));
          float x1 = v0[j], x2 = v1[j];
          float r1 = x1 * cs.x - x2 * cs.y, r2 = x1 * cs.y + x2 * cs.x;
          int cpos = s & 127;
          float sc = isK ? 0.0625f * __expf(-(float)(cpos + 1) * lg) : __expf((float)(cpos + 1) * lg);
          o1[j] = r1 * sc;
          o2[j] = r2 * sc;
        }
        int p1 = fi, p2 = 128 + fi;
        bf16_t* dst = isK ? p.Kd : p.Qd;
#pragma unroll
        for (int j = 0; j < 4; j++) {
          long s = s0 + row0 + j;
          dst[(bh * S_ + s) * 256 + p1] = f2bf(o1[j]);
          dst[(bh * S_ + s) * 256 + p2] = f2bf(o2[j]);
        }
        if (isK) {
          long s = s0 + row0;
          *(uint2*)(p.KdT + ((bh * 64 + (s >> 7)) * 256 + p1) * 128 + (s & 127)) = make_uint2(pack2(o1[0], o1[1]), pack2(o1[2], o1[3]));
          *(uint2*)(p.KdT + ((bh * 64 + (s >> 7)) * 256 + p2) * 128 + (s & 127)) = make_uint2(pack2(o2[0], o2[1]), pack2(o2[2], o2[3]));
        }
      });
    } else if (tn < 32) {
      const int hd = (tn - 16) >> 2, e0 = ((tn - 16) & 3) * 128;
      const long bh = b * 4 + hd;
      epi_pairs256(acc, [&](int row0, int col0, const float* v0, const float* v1) {
        long s = s0 + row0;
        *(uint2*)(p.VT + ((bh * 64 + (s >> 7)) * 512 + e0 + col0) * 128 + (s & 127)) = make_uint2(pack2(v0[0], v0[1]), pack2(v0[2], v0[3]));
        *(uint2*)(p.VT + ((bh * 64 + (s >> 7)) * 512 + e0 + col0 + 64) * 128 + (s & 127)) = make_uint2(pack2(v1[0], v1[1]), pack2(v1[2], v1[3]));
      });
    } else {
      const int c0 = (tn - 32) * 128;
      epi_pairs256(acc, [&](int row0, int col0, const float* v0, const float* v1) {
#pragma unroll
        for (int j = 0; j < 4; j++) {
          long t = m0 + row0 + j;
          p.Gs[t * 2048 + c0 + col0] = f2bf(silu_f(v0[j]));
          p.Gs[t * 2048 + c0 + col0 + 64] = f2bf(silu_f(v1[j]));
        }
      });
    }
  }
}

__device__ __forceinline__ void ret_up_phase(const P& p, unsigned char* smem) {
  const int nU = 8 * 64 * 8;
  const int nP = 8 * 64;
  for (int it0 = blockIdx.x; it0 < nU + nP; it0 += gridDim.x) {
    const int it = item_swz(it0, nU + nP);
    f32x16 acc[2][2];
    zero_acc(acc);
    if (it < nU) {
      int sub = it & 7, n = (it >> 3) & 63, bh = it >> 9;
      int et = sub >> 1, dt = sub & 1;
      gemm_tile(p.VT + ((long)(bh * 64 + n) * 512 + et * 128) * 128, 128, p.KdT + ((long)(bh * 64 + n) * 256 + dt * 128) * 128, 128,
                128, acc, smem);
      bf16_t* dst = p.ST + ((long)(bh * 64 + n) * 512 + et * 128) * 256 + dt * 128;
      epi_pairs(acc, [&](int row0, int col0, const float* v0, const float* v1) {
#pragma unroll
        for (int j = 0; j < 4; j++) {
          dst[(long)(row0 + j) * 256 + col0] = f2bf(v0[j]);
          dst[(long)(row0 + j) * 256 + col0 + 64] = f2bf(v1[j]);
        }
      });
    } else {
      int i2 = it - nU;
      int n = i2 & 63, bh = i2 >> 6;
      gemm_tile(p.Qd + ((long)bh * S_ + n * 128) * 256, 256, p.Kd + ((long)bh * S_ + n * 128) * 256, 256, 256, acc, smem);
      bf16_t* dst = p.Pb + (long)(bh * 64 + n) * 128 * 128;
      epi_pairs(acc, [&](int row0, int col0, const float* v0, const float* v1) {
#pragma unroll
        for (int j = 0; j < 4; j++) {
          int r = row0 + j;
          dst[r * 128 + col0] = f2bf(r >= col0 ? v0[j] : 0.f);
          dst[r * 128 + col0 + 64] = f2bf(r >= col0 + 64 ? v1[j] : 0.f);
        }
      });
    }
  }
}

__device__ __forceinline__ void ret_scan_phase(const P& p) {
  const long per = 512L * 256;
  long total = 8L * per / 8;
  for (long i = (long)blockIdx.x * 256 + otid(); i < total; i += (long)gridDim.x * 256) {
    long e = i * 8;
    int bh = (int)(e / per);
    long off = e % per;
    int hd = bh & 3;
    float cdec = __expf(128.f * log1pf(-exp2f(-5.0f - (float)hd)));
    float st[8];
#pragma unroll
    for (int j = 0; j < 8; j++) st[j] = 0.f;
    bf16_t* base = p.ST + (long)bh * 64 * per + off;
    uint4 u = *(const uint4*)base;
    for (int n = 0; n < 64; n++) {
      uint4 un = u;
      if (n + 1 < 64) un = *(const uint4*)(base + (long)(n + 1) * per);
      *(uint4*)(base + (long)n * per) = make_uint4(pack2(st[0], st[1]), pack2(st[2], st[3]), pack2(st[4], st[5]), pack2(st[6], st[7]));
      unsigned w[4] = {u.x, u.y, u.z, u.w};
#pragma unroll
      for (int j = 0; j < 4; j++) {
        st[2 * j] = cdec * (st[2 * j] + __uint_as_float(w[j] << 16));
        st[2 * j + 1] = cdec * (st[2 * j + 1] + __uint_as_float(w[j] & 0xffff0000u));
      }
      u = un;
    }
  }
}

__device__ __forceinline__ void ret_out_phase(const P& p, unsigned char* smem) {
  const int nitems = 8 * 64 * 4;
  for (int it0 = blockIdx.x; it0 < nitems; it0 += gridDim.x) {
    const int it = item_swz(it0, nitems);
    int et = it & 3, n = (it >> 2) & 63, bh = it >> 8;
    int b = bh >> 2, hd = bh & 3;
    f32x16 acc[2][2];
    zero_acc(acc);
    gemm_tile(p.Pb + (long)(bh * 64 + n) * 128 * 128, 128, p.VT + ((long)(bh * 64 + n) * 512 + et * 128) * 128, 128, 128, acc, smem);
    gemm_tile(p.Qd + ((long)bh * S_ + n * 128) * 256, 256, p.ST + ((long)(bh * 64 + n) * 512 + et * 128) * 256, 256, 256, acc, smem);
    bf16_t* dst = p.Ob + ((long)b * S_ + n * 128) * 2048 + hd * 512 + et * 128;
    epi_pairs(acc, [&](int row0, int col0, const float* v0, const float* v1) {
#pragma unroll
      for (int j = 0; j < 4; j++) {
        dst[(long)(row0 + j) * 2048 + col0] = f2bf(v0[j]);
        dst[(long)(row0 + j) * 2048 + col0 + 64] = f2bf(v1[j]);
      }
    });
  }
}

__device__ __forceinline__ void ret_gn_phase(const P& p) {
  const int tid_ = otid(); const int lane = tid_ & 63, wave = tid_ >> 6;
  for (int t = blockIdx.x * 4 + wave; t < T_; t += gridDim.x * 4) {
#pragma unroll
    for (int hd = 0; hd < 4; hd++) {
      long off = (long)t * 2048 + hd * 512 + lane * 8;
      uint4 o = *(const uint4*)(p.Ob + off);
      uint4 g = *(const uint4*)(p.Gs + off);
      unsigned ow[4] = {o.x, o.y, o.z, o.w}, gw[4] = {g.x, g.y, g.z, g.w};
      float ov[8], gv[8];
#pragma unroll
      for (int j = 0; j < 4; j++) {
        ov[2 * j] = __uint_as_float(ow[j] << 16);
        ov[2 * j + 1] = __uint_as_float(ow[j] & 0xffff0000u);
        gv[2 * j] = __uint_as_float(gw[j] << 16);
        gv[2 * j + 1] = __uint_as_float(gw[j] & 0xffff0000u);
      }
      float s = 0.f;
#pragma unroll
      for (int j = 0; j < 8; j++) s += ov[j];
      float mu = wave_allsum(s) * (1.f / 512.f);
      float q = 0.f;
#pragma unroll
      for (int j = 0; j < 8; j++) q += (ov[j] - mu) * (ov[j] - mu);
      float rstd = rsqrtf(wave_allsum(q) * (1.f / 512.f) + LN_EPS_);
      float r[8];
#pragma unroll
      for (int j = 0; j < 8; j++) r[j] = gv[j] * (ov[j] - mu) * rstd;
      *(uint4*)(p.Gs + off) = make_uint4(pack2(r[0], r[1]), pack2(r[2], r[3]), pack2(r[4], r[5]), pack2(r[6], r[7]));
    }
  }
}

__device__ __forceinline__ void wo_phase(const P& p, int layer, const bf16_t* A, const bf16_t* WoT, int K, unsigned char* smem) {
  const float* xres = layer == 0 ? p.x : p.xbuf;
  const int ntn = 8, ntm = 64;
#pragma unroll 1
  for (int it = blockIdx.x; it < ntn * ntm; it += gridDim.x) {
    int tn, tm;
    tile_map(it, ntm, ntn, 1, tm, tn);
    f32x16 acc[2][4];
#pragma unroll
    for (int i = 0; i < 2; i++)
#pragma unroll
      for (int j = 0; j < 4; j++)
#pragma unroll
        for (int r = 0; r < 16; r++) acc[i][j][r] = 0.f;
    gemm_tile256(A + (long)tm * 256 * K, K, WoT + (long)tn * 128 * K, K, K, acc, smem);
    const int m0 = tm * 256, n0 = tn * 128;
    const int b = m0 / S_;
    const float* g1 = p.mods + (layer * 2 + b) * 6144 + 2048;
    epi_pairs256(acc, [&](int row0, int col0, const float* v0, const float* v1) {
      int c = n0 + col0;
      float ga = g1[c], gb = g1[c + 64];
#pragma unroll
      for (int j = 0; j < 4; j++) {
        long o = (long)(m0 + row0 + j) * 1024 + c;
        p.xbuf[o] = ALPHA_ * xres[o] + ga * v0[j];
        p.xbuf[o + 64] = ALPHA_ * xres[o + 64] + gb * v1[j];
      }
    });
  }
}

__device__ __forceinline__ void ln1_phase(const P& p, int layer) {
  const int tid_ = otid(); const int lane = tid_ & 63, wave = tid_ >> 6;
  const float* lg = p.ln_g + (layer * 2 + 0) * 1024;
  const float* lb = p.ln_b + (layer * 2 + 0) * 1024;
  for (int t = blockIdx.x * 4 + wave; t < T_; t += gridDim.x * 4) {
    int b = t / S_;
    const float* md = p.mods + (layer * 2 + b) * 6144;
    float* xr = p.xbuf + (long)t * 1024;
    float z[16];
#pragma unroll
    for (int j = 0; j < 2; j++) {
      float4 a = *(const float4*)(xr + j * 512 + lane * 8), bq = *(const float4*)(xr + j * 512 + lane * 8 + 4);
      z[j * 8 + 0] = a.x; z[j * 8 + 1] = a.y; z[j * 8 + 2] = a.z; z[j * 8 + 3] = a.w;
      z[j * 8 + 4] = bq.x; z[j * 8 + 5] = bq.y; z[j * 8 + 6] = bq.z; z[j * 8 + 7] = bq.w;
    }
    float s = 0.f;
#pragma unroll
    for (int j = 0; j < 16; j++) s += z[j];
    float mu = wave_allsum(s) * (1.f / 1024.f);
    float q = 0.f;
#pragma unroll
    for (int j = 0; j < 16; j++) q += (z[j] - mu) * (z[j] - mu);
    float rstd = rsqrtf(wave_allsum(q) * (1.f / 1024.f) + LN_EPS_);
#pragma unroll
    for (int j = 0; j < 2; j++) {
      int k0 = j * 512 + lane * 8;
      float xo[8], h[8];
#pragma unroll
      for (int i = 0; i < 8; i++) {
        xo[i] = (z[j * 8 + i] - mu) * rstd * lg[k0 + i] + lb[k0 + i];
        h[i] = xo[i] * (1.f + md[4 * 1024 + k0 + i]) + md[3 * 1024 + k0 + i];
      }
      *(float4*)(xr + k0) = make_float4(xo[0], xo[1], xo[2], xo[3]);
      *(float4*)(xr + k0 + 4) = make_float4(xo[4], xo[5], xo[6], xo[7]);
      *(uint4*)(p.hbuf + (long)t * 1024 + k0) = make_uint4(pack2(h[0], h[1]), pack2(h[2], h[3]), pack2(h[4], h[5]), pack2(h[6], h[7]));
    }
  }
}

#define KSTR 132
__device__ __forceinline__ void peer_qscore_phase(const P& p, int layer, unsigned char* smem) {
  const bf16_t* W = p.wqT + (long)layer * 2048 * 1024;
  const bf16_t* keys = p.keysB + (long)layer * 16 * 128 * 128;
  bf16_t* sKeys = (bf16_t*)smem;
#pragma unroll 1
  for (int it = blockIdx.x; it < 16 * 128; it += gridDim.x) {
    int hc, tm;
    tile_map(it, 128, 16, 2, tm, hc);
    f32x16 acc[4];
#pragma unroll
    for (int i = 0; i < 4; i++)
#pragma unroll
      for (int r = 0; r < 16; r++) acc[i][r] = 0.f;
    gemm_tile_w41(W + (long)hc * 128 * 1024, 1024, p.hbuf + (long)tm * 128 * 1024, 1024, 1024, acc, smem);
    const int tid = otid(), lane = tid & 63, wave = tid >> 6, hf = lane >> 5;
    {
      const bf16_t* kg = keys + (long)hc * 128 * 128;
#pragma unroll
      for (int i = 0; i < 8; i++) {
        int ch = tid + i * 256;
        int r = ch >> 4, c = (ch & 15) * 8;
        uint4 v = *(const uint4*)(kg + r * 128 + c);
        *(uint2*)(sKeys + r * KSTR + c) = make_uint2(v.x, v.y);
        *(uint2*)(sKeys + r * KSTR + c + 4) = make_uint2(v.z, v.w);
      }
    }
    bf16x8 qb[8];
#pragma unroll
    for (int i2 = 0; i2 < 8; i2++) {
      const int mi = i2 >> 1, u = i2 & 1;
      union { unsigned w[4]; bf16x8 v; } pf;
#pragma unroll
      for (int j = 0; j < 4; j++) pf.w[j] = pack2(acc[mi][8 * u + 2 * j], acc[mi][8 * u + 2 * j + 1]);
      qb[i2] = pf.v;
    }
    __syncthreads();
    f32x16 sc[4];
#pragma unroll
    for (int kt = 0; kt < 4; kt++) {
#pragma unroll
      for (int r = 0; r < 16; r++) sc[kt][r] = 0.f;
#pragma unroll
      for (int i2 = 0; i2 < 8; i2++) {
        const bf16_t* kp = sKeys + (kt * 32 + (lane & 31)) * KSTR + i2 * 16 + hf * 4;
        uint2 lo = *(const uint2*)kp, hi = *(const uint2*)(kp + 8);
        union { unsigned w[4]; bf16x8 v; } kf;
        kf.w[0] = lo.x; kf.w[1] = lo.y; kf.w[2] = hi.x; kf.w[3] = hi.y;
        sc[kt] = mfma32(kf.v, qb[i2], sc[kt]);
      }
    }
    float top[16];
#pragma unroll
    for (int i = 0; i < 16; i++) top[i] = -3.0e38f;
    const int jb = 127 - hf * 4;
#pragma unroll
    for (int kt = 0; kt < 4; kt++)
#pragma unroll
      for (int r = 0; r < 16; r++) {
        const int jc = kt * 32 + (r >> 2) * 8 + (r & 3);
        float x = __int_as_float((__float_as_int(sc[kt][r]) & ~127) | (jb - jc));
#pragma unroll
        for (int i = 15; i >= 1; i--) top[i] = __builtin_amdgcn_fmed3f(top[i - 1], top[i], x);
        top[0] = fmaxf(top[0], x);
      }
    float oth[16];
#pragma unroll
    for (int i = 0; i < 16; i++) oth[i] = __shfl_xor(top[i], 32);
#pragma unroll
    for (int k = 0; k < 16; k++) {
      float x = oth[k];
#pragma unroll
      for (int i = 15; i >= 1; i--) top[i] = __builtin_amdgcn_fmed3f(top[i - 1], top[i], x);
      top[0] = fmaxf(top[0], x);
    }
    if (hf == 0) {
      const int token = tm * 128 + wave * 32 + lane;
      float4* d = (float4*)(p.topk + ((long)token * 16 + hc) * 16);
      d[0] = make_float4(top[0], top[1], top[2], top[3]);
      d[1] = make_float4(top[4], top[5], top[6], top[7]);
      d[2] = make_float4(top[8], top[9], top[10], top[11]);
      d[3] = make_float4(top[12], top[13], top[14], top[15]);
    }
  }
}

__device__ __forceinline__ void expert_dot(const int4& uq, const f32x2 (&h2)[8], float& d) {
  f32x2 acc = {0.f, 0.f};
  const int uw[4] = {uq.x, uq.y, uq.z, uq.w};
#pragma unroll
  for (int q = 0; q < 4; q++) {
    acc = __builtin_elementwise_fma(__builtin_amdgcn_cvt_pk_f32_fp8(uw[q], false), h2[2 * q], acc);
    acc = __builtin_elementwise_fma(__builtin_amdgcn_cvt_pk_f32_fp8(uw[q], true), h2[2 * q + 1], acc);
  }
  d = acc.x + acc.y;
}
__device__ __forceinline__ void expert_axpy(const int4& vq, float a, f32x2 (&y2)[8]) {
  const int vw[4] = {vq.x, vq.y, vq.z, vq.w};
  const f32x2 a2 = {a, a};
#pragma unroll
  for (int q = 0; q < 4; q++) {
    y2[2 * q] = __builtin_elementwise_fma(__builtin_amdgcn_cvt_pk_f32_fp8(vw[q], false), a2, y2[2 * q]);
    y2[2 * q + 1] = __builtin_elementwise_fma(__builtin_amdgcn_cvt_pk_f32_fp8(vw[q], true), a2, y2[2 * q + 1]);
  }
}
#define EXG 4
__device__ __forceinline__ void peer_expert_phase(const P& p, int layer, unsigned char* smem, const bool dry) {
  const int tid_ = otid();
  const int lane = tid_ & 63, wave = tid_ >> 6;
  int4* elist = (int4*)smem + wave * 128;
  int* tkl = (int*)(smem + 8192) + wave * 256;
  int ci = 0, cj = 0, cnt = 0;
  bool isc = false;
  for (int i = 0; i < 16; i++)
    for (int j = 0; j < 16; j++)
      if ((i + 1) * (j + 1) <= 16) {
        if (cnt == lane) { ci = i; cj = j; isc = true; }
        cnt++;
      }
  const unsigned char* U = p.uB + (long)layer * 16384 * 2048;
  const unsigned char* V = U + 1024;
  const float* SU = p.su + layer * 16384;
  const float* SV = p.sv + layer * 16384;
  const float* lg = p.ln_g + (layer * 2 + 1) * 1024;
  const float* lb = p.ln_b + (layer * 2 + 1) * 1024;
  __syncthreads();
#pragma unroll 1
  for (int t = blockIdx.x * 4 + wave; t < T_; t += gridDim.x * 4) {
    int b = t / S_;
    const float* md = p.mods + (layer * 2 + b) * 6144;
    float* xr = p.xbuf + (long)t * 1024;
    float xv[16];
    f32x2 h2[8];
#pragma unroll
    for (int j = 0; j < 2; j++) {
      float4 a = *(const float4*)(xr + j * 512 + lane * 8), bq = *(const float4*)(xr + j * 512 + lane * 8 + 4);
      xv[j * 8 + 0] = a.x; xv[j * 8 + 1] = a.y; xv[j * 8 + 2] = a.z; xv[j * 8 + 3] = a.w;
      xv[j * 8 + 4] = bq.x; xv[j * 8 + 5] = bq.y; xv[j * 8 + 6] = bq.z; xv[j * 8 + 7] = bq.w;
    }
#pragma unroll
    for (int j = 0; j < 2; j++)
#pragma unroll
      for (int i = 0; i < 8; i += 2) {
        int k = j * 512 + lane * 8 + i;
        f32x2 hh;
        hh.x = xv[j * 8 + i] * (1.f + md[4 * 1024 + k]) + md[3 * 1024 + k];
        hh.y = xv[j * 8 + i + 1] * (1.f + md[4 * 1024 + k + 1]) + md[3 * 1024 + k + 1];
        h2[(j * 8 + i) >> 1] = hh;
      }
    ((int4*)tkl)[lane] = ((const int4*)(p.topk + (long)t * 256))[lane];
    __builtin_amdgcn_wave_barrier();
#pragma unroll 1
    for (int head = 0; head < 8; head++) {
      int key = 0;
      if (lane < 32) key = tkl[head * 32 + lane];
      int k0 = __shfl(key, ci), k1 = __shfl(key, 16 + cj);
      float s = isc ? (__int_as_float(k0 & ~127) + __int_as_float(k1 & ~127)) : -3.0e38f;
      int rank = 0;
#pragma unroll
      for (int c2 = 0; c2 < 50; c2++) {
        float s2 = __int_as_float(__builtin_amdgcn_readlane(__float_as_int(s), c2));
        rank += (s2 > s || (s2 == s && c2 < lane)) ? 1 : 0;
      }
      bool sel = isc && rank < 16;
      unsigned long long b0 = __ballot(isc && rank == 0);
      int l0 = __ffsll((long long)b0) - 1;
      float mx = __shfl(s, l0);
      float w = sel ? __expf(s - mx) : 0.f;
      float tot = wave_allsum_fast(w);
      w = w / tot;
      if (sel) {
        int e = (127 - (k0 & 127)) * 128 + (127 - (k1 & 127));
        elist[head * 16 + rank] = make_int4(e, __float_as_int(w), 0, 0);
      }
    }
    __builtin_amdgcn_wave_barrier();
    f32x2 y2[8];
#pragma unroll
    for (int i = 0; i < 8; i++) y2[i] = (f32x2){0.f, 0.f};
    int4 ua[EXG], va[EXG], ub[EXG], vb[EXG];
#pragma unroll
    for (int i = 0; i < EXG; i++) {
      int e = elist[i].x;
      ua[i] = *((const int4*)(U + (long)e * 2048) + lane);
      va[i] = *((const int4*)(V + (long)e * 2048) + lane);
    }
    {
      int e0 = elist[lane].x, e1 = elist[lane + 64].x;
      float su0 = SU[e0], sv0 = SV[e0], su1 = SU[e1], sv1 = SV[e1];
      elist[lane].z = __float_as_int(su0);
      elist[lane].w = __float_as_int(sv0);
      elist[lane + 64].z = __float_as_int(su1);
      elist[lane + 64].w = __float_as_int(sv1);
    }
    __builtin_amdgcn_wave_barrier();
#pragma unroll 1
    for (int g = 0; g < 128 / EXG; g += 2) {
#pragma unroll
      for (int i = 0; i < EXG; i++) {
        int e = elist[(g + 1) * EXG + i].x;
        ub[i] = *((const int4*)(U + (long)e * 2048) + lane);
        vb[i] = *((const int4*)(V + (long)e * 2048) + lane);
      }
#pragma unroll
      for (int i = 0; i < EXG; i++) {
        int4 ew = elist[g * EXG + i];
        float d;
        expert_dot(ua[i], h2, d);
        d = wave_allsum_fast(d) * __int_as_float(ew.z);
        float a = gelu_t(d) * __int_as_float(ew.y) * __int_as_float(ew.w);
        expert_axpy(va[i], a, y2);
      }
      if (g + 2 < 128 / EXG) {
#pragma unroll
        for (int i = 0; i < EXG; i++) {
          int e = elist[(g + 2) * EXG + i].x;
          ua[i] = *((const int4*)(U + (long)e * 2048) + lane);
          va[i] = *((const int4*)(V + (long)e * 2048) + lane);
        }
      }
#pragma unroll
      for (int i = 0; i < EXG; i++) {
        int4 ew = elist[(g + 1) * EXG + i];
        float d;
        expert_dot(ub[i], h2, d);
        d = wave_allsum_fast(d) * __int_as_float(ew.z);
        float a = gelu_t(d) * __int_as_float(ew.y) * __int_as_float(ew.w);
        expert_axpy(vb[i], a, y2);
      }
    }
    __builtin_amdgcn_wave_barrier();
    float z[16];
    float s = 0.f;
#pragma unroll
    for (int j = 0; j < 2; j++)
#pragma unroll
      for (int i = 0; i < 8; i++) {
        int k = j * 512 + lane * 8 + i;
        float yv = (i & 1) ? y2[(j * 8 + i) >> 1].y : y2[(j * 8 + i) >> 1].x;
        z[j * 8 + i] = ALPHA_ * xv[j * 8 + i] + md[5 * 1024 + k] * yv;
        s += z[j * 8 + i];
      }
    float mu = wave_allsum_fast(s) * (1.f / 1024.f);
    float q = 0.f;
#pragma unroll
    for (int j = 0; j < 16; j++) q += (z[j] - mu) * (z[j] - mu);
    float rstd = rsqrtf(wave_allsum_fast(q) * (1.f / 1024.f) + LN_EPS_);
    float* dstx = dry ? ((float*)p.qp + (long)t * 1024) : ((layer == 3) ? (p.out + (long)t * 1024) : xr);
    const float* mdn = p.mods + (((layer + 1) & 3) * 2 + b) * 6144;
    const float* kvm = p.kvmod + b * 2048;
#pragma unroll
    for (int j = 0; j < 2; j++) {
      int k0 = j * 512 + lane * 8;
      float xo[8], h[8], xs[8];
#pragma unroll
      for (int i = 0; i < 8; i++) {
        xo[i] = (z[j * 8 + i] - mu) * rstd * lg[k0 + i] + lb[k0 + i];
        h[i] = xo[i] * (1.f + mdn[1024 + k0 + i]) + mdn[k0 + i];
        xs[i] = xo[i] * (1.f + kvm[1024 + k0 + i]) + kvm[k0 + i];
      }
      *(float4*)(dstx + k0) = make_float4(xo[0], xo[1], xo[2], xo[3]);
      *(float4*)(dstx + k0 + 4) = make_float4(xo[4], xo[5], xo[6], xo[7]);
      if (layer < 3 && !dry)
        *(uint4*)(p.hbuf + (long)t * 1024 + k0) = make_uint4(pack2(h[0], h[1]), pack2(h[2], h[3]), pack2(h[4], h[5]), pack2(h[6], h[7]));
      if (layer == 1 && !dry)
        *(uint4*)(p.xsbuf + (long)t * 1024 + k0) = make_uint4(pack2(xs[0], xs[1]), pack2(xs[2], xs[3]), pack2(xs[4], xs[5]), pack2(xs[6], xs[7]));
    }
  }
}

__device__ __forceinline__ void kv_proj_phase(const P& p, unsigned char* smem) {
  const int ntn = 12, ntm = 128;
  const long partsz = 8L * S_ * 64;
  for (int it = blockIdx.x; it < ntn * ntm; it += gridDim.x) {
    int tn, tm;
    tile_map(it, ntm, ntn, 1, tm, tn);
    f32x16 acc[2][2];
    zero_acc(acc);
    gemm_tile(p.xsbuf + (long)tm * 128 * 1024, 1024, p.kvWT + (long)tn * 128 * 1024, 1024, 1024, acc, smem);
    const int m0 = tm * 128, b = m0 / S_, s0 = m0 % S_;
    const int part = tn >> 1, ga = (tn & 1) * 2;
    bf16_t* base = p.kvbuf + part * partsz;
    const bool tr = (part == 3 || part == 5);
    epi_pairs(acc, [&](int row0, int col0, const float* v0, const float* v1) {
      long bg0 = b * 4 + ga, bg1 = bg0 + 1;
      int d = col0;
      long s = s0 + row0;
      if (tr) {
        *(uint2*)(base + ((bg0 * 64 + (s >> 7)) * 64 + d) * 128 + (s & 127)) = make_uint2(pack2(v0[0], v0[1]), pack2(v0[2], v0[3]));
        *(uint2*)(base + ((bg1 * 64 + (s >> 7)) * 64 + d) * 128 + (s & 127)) = make_uint2(pack2(v1[0], v1[1]), pack2(v1[2], v1[3]));
      } else {
#pragma unroll
        for (int j = 0; j < 4; j++) {
          base[(bg0 * S_ + s + j) * 64 + d] = f2bf(v0[j]);
          base[(bg1 * S_ + s + j) * 64 + d] = f2bf(v1[j]);
        }
      }
    });
  }
}

__device__ __forceinline__ void cmp1_phase(const P& p, unsigned char* smem) {
  const long partsz = 8L * S_ * 64;
  for (int it = blockIdx.x; it < 2 * 8 * 4 * 2; it += gridDim.x) {
    int tn = it & 1, tm = (it >> 1) & 3, bg = (it >> 3) & 7, c = it >> 6;
    f32x16 acc[2][2];
    zero_acc(acc);
    gemm_tile(p.kvbuf + c * partsz + (long)bg * S_ * 64 + (long)tm * 128 * 1024, 1024, p.w1T + ((long)c * 256 + tn * 128) * 2048, 2048,
              2048, acc, smem);
    bf16_t* dst = p.hid + ((long)(c * 8 + bg) * 512 + tm * 128) * 256 + tn * 128;
    const float* bp = p.biasp + c * 256 + tn * 128;
    epi_pairs(acc, [&](int row0, int col0, const float* v0, const float* v1) {
      float ba = bp[col0], bb = bp[col0 + 64];
#pragma unroll
      for (int j = 0; j < 4; j++) {
        dst[(long)(row0 + j) * 256 + col0] = f2bf(gelu_t(v0[j] + ba));
        dst[(long)(row0 + j) * 256 + col0 + 64] = f2bf(gelu_t(v1[j] + bb));
      }
    });
  }
}

__device__ __forceinline__ void cmp2_phase(const P& p, unsigned char* smem) {
  for (int it = blockIdx.x; it < 2 * 8 * 4; it += gridDim.x) {
    int tm = it & 3, bg = (it >> 2) & 7, c = it >> 5;
    f32x16 acc[2][2];
    zero_acc(acc);
    gemm_tile(p.hid + ((long)(c * 8 + bg) * 512 + tm * 128) * 256, 256, p.w2T + (long)c * 128 * 256, 256, 256, acc, smem);
    epi_pairs(acc, [&](int row0, int col0, const float* v0, const float* v1) {
      int n = tm * 128 + row0;
      if (c == 0) {
#pragma unroll
        for (int j = 0; j < 4; j++) p.Kc[((long)bg * 512 + n + j) * 64 + col0] = f2bf(v0[j]);
      } else {
        *(uint2*)(p.VcT + ((long)bg * 64 + col0) * 512 + n) = make_uint2(pack2(v0[0], v0[1]), pack2(v0[2], v0[3]));
      }
    });
  }
}

__device__ __forceinline__ void nsa_q_phase(const P& p, int lb, unsigned char* smem) {
  const bf16_t* W = p.nsaWinT + (long)lb * 1152 * 1024;
  const int ntn = 9, ntm = 128;
  for (int it = blockIdx.x; it < ntn * ntm; it += gridDim.x) {
    int tn, tm;
    tile_map(it, ntm, ntn, 1, tm, tn);
    f32x16 acc[2][2];
    zero_acc(acc);
    gemm_tile(p.hbuf + (long)tm * 128 * 1024, 1024, W + (long)tn * 128 * 1024, 1024, 1024, acc, smem);
    const int m0 = tm * 128, n0 = tn * 128;
    epi_pairs(acc, [&](int row0, int col0, const float* v0, const float* v1) {
#pragma unroll
      for (int j = 0; j < 4; j++) {
        long t = m0 + row0 + j;
        int ca = n0 + col0, cb = ca + 64;
        if (ca < 1024) p.Qn[t * 1024 + ca] = f2bf(v0[j] * 0.18033688011112042f);
        else if (ca < 1072) p.gate[t * 48 + ca - 1024] = sigmoid_f(v0[j]);
        if (cb < 1024) p.Qn[t * 1024 + cb] = f2bf(v1[j] * 0.18033688011112042f);
        else if (cb < 1072) p.gate[t * 48 + cb - 1024] = sigmoid_f(v1[j]);
      }
    });
  }
}

#define VSTR 132
__device__ __forceinline__ void stage_K(const bf16_t* __restrict__ src, bf16_t* sK) {
  const int tid = otid();
#pragma unroll
  for (int i = 0; i < 4; i++) {
    int ch = tid + i * 256;
    int r = ch >> 3, c = (ch & 7) * 8;
    *(uint4*)(sK + r * LSTR + c) = *(const uint4*)(src + r * 64 + c);
  }
}
__device__ __forceinline__ void stage_VT(const bf16_t* __restrict__ src, long ld, bf16_t* sV) {
  const int tid = otid();
#pragma unroll
  for (int i = 0; i < 4; i++) {
    int ch = tid + i * 256;
    int r = ch >> 4, c = (ch & 15) * 8;
    uint4 v = *(const uint4*)(src + (long)r * ld + c);
    *(uint2*)(sV + r * VSTR + c) = make_uint2(v.x, v.y);
    *(uint2*)(sV + r * VSTR + c + 4) = make_uint2(v.z, v.w);
  }
}
__device__ __forceinline__ void attn_qk(const bf16_t* sK, const bf16x8 (&qf)[4], f32x16 (&st)[2], int lane) {
#pragma unroll
  for (int mi = 0; mi < 2; mi++) {
#pragma unroll
    for (int r = 0; r < 16; r++) st[mi][r] = 0.f;
#pragma unroll
    for (int kk = 0; kk < 4; kk++) {
      bf16x8 kf = *(const bf16x8*)(sK + (mi * 32 + (lane & 31)) * LSTR + kk * 16 + (lane >> 5) * 8);
      st[mi] = mfma32(kf, qf[kk], st[mi]);
    }
  }
}
__device__ __forceinline__ void attn_pv(const bf16_t* sV, const f32x16 (&pt)[2], f32x16 (&o)[2], int lane) {
#pragma unroll
  for (int i2 = 0; i2 < 4; i2++) {
    const int mi = i2 >> 1, u = i2 & 1;
    union { unsigned w[4]; bf16x8 v; } pf;
#pragma unroll
    for (int j = 0; j < 4; j++) pf.w[j] = pack2(pt[mi][8 * u + 2 * j], pt[mi][8 * u + 2 * j + 1]);
#pragma unroll
    for (int di = 0; di < 2; di++) {
      const bf16_t* vp = sV + (di * 32 + (lane & 31)) * VSTR + i2 * 16 + (lane >> 5) * 4;
      uint2 lo = *(const uint2*)vp, hi = *(const uint2*)(vp + 8);
      union { unsigned w[4]; bf16x8 v; } vf;
      vf.w[0] = lo.x; vf.w[1] = lo.y; vf.w[2] = hi.x; vf.w[3] = hi.y;
      o[di] = mfma32(vf.v, pf.v, o[di]);
    }
  }
}
__device__ __forceinline__ void add_out(unsigned (&outp)[2][8], const f32x16 (&o)[2], float sc) {
#pragma unroll
  for (int di = 0; di < 2; di++)
#pragma unroll
    for (int j = 0; j < 8; j++) {
      float a = __uint_as_float(outp[di][j] << 16) + sc * o[di][2 * j];
      float b = __uint_as_float(outp[di][j] & 0xffff0000u) + sc * o[di][2 * j + 1];
      outp[di][j] = pack2(a, b);
    }
}
__device__ __forceinline__ void flash_branch(const int MODE, const bf16_t* __restrict__ Kg, const bf16_t* __restrict__ VTg, int kt_lo, int kt_hi,
                                             const bf16x8 (&qf)[4], int t, int q0, const unsigned* sSelq,
                                             float gate, unsigned (&outp)[2][8], bf16_t* sK, bf16_t* sV, int lane) {
  float m = -1e30f, l = 0.f;
  f32x16 o[2];
#pragma unroll
  for (int di = 0; di < 2; di++)
#pragma unroll
    for (int r = 0; r < 16; r++) o[di][r] = 0.f;
  const int tid = otid();
  lane = tid & 63;
  const int hf = lane >> 5;
  const int wlo = (MODE == 2) ? (q0 + 31 - 512) : -1;
  uint4 k_0, k_1, k_2, k_3, v_0, v_1, v_2, v_3;
  const bf16_t* kp = Kg + (long)(tid >> 3) * 64 + (tid & 7) * 8;
  const bf16_t* vp = VTg + (long)(tid >> 4) * 128 + (tid & 15) * 8;
  bf16_t* skw = sK + (tid >> 3) * LSTR + (tid & 7) * 8;
  bf16_t* svw = sV + (tid >> 4) * VSTR + (tid & 15) * 8;
#define FB_LOAD(KT)                                                    \
  k_0 = *(const uint4*)(kp + (long)(KT) * 8192);                       \
  k_1 = *(const uint4*)(kp + (long)(KT) * 8192 + 32 * 64);             \
  k_2 = *(const uint4*)(kp + (long)(KT) * 8192 + 64 * 64);             \
  k_3 = *(const uint4*)(kp + (long)(KT) * 8192 + 96 * 64);             \
  v_0 = *(const uint4*)(vp + (long)(KT) * 8192);                       \
  v_1 = *(const uint4*)(vp + (long)(KT) * 8192 + 16 * 128);            \
  v_2 = *(const uint4*)(vp + (long)(KT) * 8192 + 32 * 128);            \
  v_3 = *(const uint4*)(vp + (long)(KT) * 8192 + 48 * 128);
#define FB_STORE()                                                     \
  *(uint4*)(skw) = k_0;                                                \
  *(uint4*)(skw + 32 * LSTR) = k_1;                                    \
  *(uint4*)(skw + 64 * LSTR) = k_2;                                    \
  *(uint4*)(skw + 96 * LSTR) = k_3;                                    \
  *(uint2*)(svw) = make_uint2(v_0.x, v_0.y);                           \
  *(uint2*)(svw + 4) = make_uint2(v_0.z, v_0.w);                       \
  *(uint2*)(svw + 16 * VSTR) = make_uint2(v_1.x, v_1.y);               \
  *(uint2*)(svw + 16 * VSTR + 4) = make_uint2(v_1.z, v_1.w);           \
  *(uint2*)(svw + 32 * VSTR) = make_uint2(v_2.x, v_2.y);               \
  *(uint2*)(svw + 32 * VSTR + 4) = make_uint2(v_2.z, v_2.w);           \
  *(uint2*)(svw + 48 * VSTR) = make_uint2(v_3.x, v_3.y);               \
  *(uint2*)(svw + 48 * VSTR + 4) = make_uint2(v_3.z, v_3.w);
  FB_LOAD(kt_lo);
#pragma unroll 1
  for (int kt = kt_lo; kt <= kt_hi; kt++) {
    unsigned two = 3u;
    if (MODE == 1) {
      unsigned wsel = sSelq[kt >> 4];
      two = (wsel >> ((2 * kt) & 31)) & 3u;
    }
    __syncthreads();
    FB_STORE();
    __syncthreads();
    if (kt < kt_hi) { FB_LOAD(kt + 1); }
#pragma unroll
    for (int half = 0; half < 2; half++) {
      f32x16 st[2];
      attn_qk(sK + half * 64 * LSTR, qf, st, lane);
      const bool bsel = (two >> half) & 1u;
      const int kbase = kt * 128 + half * 64;
      const bool interior = (kbase + 63 <= q0) && (kbase > wlo);
      float mnew, corr;
      if (interior) {
        float mx = st[0][0];
#pragma unroll
        for (int mi = 0; mi < 2; mi++)
#pragma unroll
          for (int r = 0; r < 16; r++) mx = fmaxf(mx, st[mi][r]);
        mx = bsel ? mx : -1e30f;
        mx = fmaxf(mx, __shfl_xor(mx, 32));
        mnew = fmaxf(m, mx);
        corr = ex2(m - mnew);
        const float c = bsel ? -mnew : -1e30f;
        const f32x2 c2 = {c, c};
        f32x2 ls2 = {0.f, 0.f};
#pragma unroll
        for (int mi = 0; mi < 2; mi++)
#pragma unroll
          for (int r = 0; r < 16; r += 2) {
            f32x2 v = {st[mi][r], st[mi][r + 1]};
            v = v + c2;
            v.x = ex2(v.x);
            v.y = ex2(v.y);
            st[mi][r] = v.x;
            st[mi][r + 1] = v.y;
            ls2 = ls2 + v;
          }
        l = l * corr + (ls2.x + ls2.y);
      } else {
        float mx = -1e30f;
        const int rel = bsel ? (t - (kbase + hf * 4)) : -1;
        const int rel2 = (MODE == 2) ? rel - 511 : -1000000;
#pragma unroll
        for (int mi = 0; mi < 2; mi++)
#pragma unroll
          for (int r = 0; r < 16; r++) {
            const int cr = mi * 32 + (r >> 2) * 8 + (r & 3);
            const bool valid = (cr <= rel) && (cr >= rel2);
            float sv = valid ? st[mi][r] : -1e30f;
            st[mi][r] = sv;
            mx = fmaxf(mx, sv);
          }
        mx = fmaxf(mx, __shfl_xor(mx, 32));
        mnew = fmaxf(m, mx);
        corr = ex2(m - mnew);
        float ls = 0.f;
#pragma unroll
        for (int mi = 0; mi < 2; mi++)
#pragma unroll
          for (int r = 0; r < 16; r++) {
            float sv = st[mi][r];
            float pv = (sv > -1e29f) ? ex2(sv - mnew) : 0.f;
            st[mi][r] = pv;
            ls += pv;
          }
        l = l * corr + ls;
      }
      m = mnew;
      if (__any(corr < 1.0f)) {
#pragma unroll
        for (int di = 0; di < 2; di++)
#pragma unroll
          for (int r = 0; r < 16; r++) o[di][r] *= corr;
      }
      attn_pv(sV + half * 64, st, o, lane);
    }
  }
#undef FB_LOAD
#undef FB_STORE
  float lt = l + __shfl_xor(l, 32);
  float sc = lt > 0.f ? gate / lt : 0.f;
  add_out(outp, o, sc);
}

__device__ __forceinline__ void nsa_attn_phase(const P& p, unsigned char* smem) {
  bf16_t* sK = (bf16_t*)smem;
  bf16_t* sV = (bf16_t*)(smem + 18432);
  unsigned* sImp = (unsigned*)(smem + 35328);
  unsigned* sSel = (unsigned*)(smem + 51840);
  unsigned* sAny = (unsigned*)(smem + 52352);
  const long partsz = 8L * S_ * 64;
  const int tid = otid(), lane = tid & 63, wave = tid >> 6;
  const int qi = lane & 31, hf = lane >> 5;
#pragma unroll 1
  for (int it0 = blockIdx.x; it0 < 2048; it0 += gridDim.x) {
    const int it = item_swz(it0, 2048);
    int bg = it >> 8, qtr = it & 255;
    int qt = ((bg >> 1) & 1) ? 255 - qtr : qtr;
    int b = bg >> 2, g = bg & 3;
    int q0 = qt * 32, t = q0 + qi, hq = g * 4 + wave;
    long tg = (long)b * S_ + t;
    bf16x8 qf[4];
    {
      const bf16_t* qptr = p.Qn + tg * 1024 + hq * 64 + hf * 8;
#pragma unroll
      for (int kk = 0; kk < 4; kk++) qf[kk] = *(const bf16x8*)(qptr + kk * 16);
    }
    const float* gp = p.gate + tg * 48 + hq * 3;
    float g0 = gp[0], g1 = gp[1], g2 = gp[2];
    __syncthreads();
    for (int i = tid; i < 32 * 129; i += 256) sImp[i] = 0u;
    if (tid < 128) sSel[tid] = 0u;
    if (tid < 4) sAny[tid] = 0u;
    unsigned outp[2][8];
#pragma unroll
    for (int di = 0; di < 2; di++)
#pragma unroll
      for (int j = 0; j < 8; j++) outp[di][j] = 0u;
    {
      const bf16_t* Kg = p.Kc + (long)bg * 512 * 64;
      const bf16_t* VTg = p.VcT + (long)bg * 64 * 512;
      int nmax = 2 * qt;
      if (nmax > 510) nmax = 510;
      int ntc = (nmax >> 7) + 1;
      int nlim = (t - 31) >> 4;
      if (nlim > 510) nlim = 510;
      const int lane = otid() & 63, qi = lane & 31, hf = lane >> 5;
      float m = -1e30f, l = 0.f;
#pragma unroll 1
      for (int kt = 0; kt < ntc; kt++) {
        __syncthreads();
        stage_K(Kg + (long)kt * 128 * 64, sK);
        __syncthreads();
#pragma unroll 1
        for (int half = 0; half < 2; half++) {
          f32x16 st[2];
          attn_qk(sK + half * 64 * LSTR, qf, st, lane);
          float mx = -1e30f;
          const int rel = nlim - (kt * 128 + half * 64 + hf * 4);
#pragma unroll
          for (int mi = 0; mi < 2; mi++)
#pragma unroll
            for (int r = 0; r < 16; r++) {
              const int cr = mi * 32 + (r >> 2) * 8 + (r & 3);
              bool valid = (cr <= rel);
              float sv = valid ? st[mi][r] : -1e30f;
              st[mi][r] = sv;
              mx = fmaxf(mx, sv);
            }
          mx = fmaxf(mx, __shfl_xor(mx, 32));
          float mnew = fmaxf(m, mx);
          float ls = 0.f;
#pragma unroll
          for (int mi = 0; mi < 2; mi++)
#pragma unroll
            for (int r = 0; r < 16; r++) {
              float sv = st[mi][r];
              ls += (sv > -1e29f) ? ex2(sv - mnew) : 0.f;
            }
          l = l * ex2(m - mnew) + ls;
          m = mnew;
        }
      }
      float lt = l + __shfl_xor(l, 32);
      float inv = lt > 0.f ? 1.f / lt : 0.f;
      f32x16 o[2];
#pragma unroll
      for (int di = 0; di < 2; di++)
#pragma unroll
        for (int r = 0; r < 16; r++) o[di][r] = 0.f;
#pragma unroll 1
      for (int kt = 0; kt < ntc; kt++) {
        __syncthreads();
        stage_K(Kg + (long)kt * 128 * 64, sK);
        stage_VT(VTg + (long)kt * 128, 512, sV);
        __syncthreads();
#pragma unroll 1
        for (int half = 0; half < 2; half++) {
          f32x16 st[2];
          attn_qk(sK + half * 64 * LSTR, qf, st, lane);
          const int rel = nlim - (kt * 128 + half * 64 + hf * 4);
#pragma unroll
          for (int mi = 0; mi < 2; mi++)
#pragma unroll
            for (int rq = 0; rq < 4; rq++) {
              int nb = kt * 128 + half * 64 + mi * 32 + rq * 8 + hf * 4;
              float pv[4];
#pragma unroll
              for (int j = 0; j < 4; j++) {
                const int cr = mi * 32 + rq * 8 + j;
                bool valid = (cr <= rel);
                pv[j] = valid ? ex2(st[mi][rq * 4 + j] - m) * inv : 0.f;
                st[mi][rq * 4 + j] = pv[j];
              }
              float mainv = pv[0] + pv[1] + pv[2] + 0.5f * pv[3];
              float spill = 0.5f * pv[3];
              int j = nb >> 2;
              if (mainv > 0.f) atomicAdd(&sImp[qi * 129 + j], (unsigned)(mainv * 67108864.f + 0.5f));
              if (spill > 0.f && j + 1 < 128) atomicAdd(&sImp[qi * 129 + j + 1], (unsigned)(spill * 67108864.f + 0.5f));
            }
          attn_pv(sV + half * 64, st, o, lane);
        }
      }
      add_out(outp, o, g0);
    }
    __syncthreads();
    for (int idx = otid(); idx < 32 * 128; idx += 256) {
      int q = idx >> 7, j = idx & 127;
      int tq = q0 + q, cur = tq >> 6;
      bool avail = (j * 64 <= tq);
      bool forced = (j == 0) || (j == cur) || (j == cur - 1);
      unsigned v = sImp[q * 129 + j];
      sImp[q * 129 + j] = avail ? ((forced ? 0x80000000u : 0u) | ((v >> 6) << 8) | (unsigned)(128 - j)) : 0u;
    }
    __syncthreads();
    {
      const int tid2 = otid();
      int q = tid2 >> 3, jg = tid2 & 7;
      unsigned myk[16];
#pragma unroll
      for (int i = 0; i < 16; i++) myk[i] = sImp[q * 129 + jg + 8 * i];
      unsigned thr = 0u;
#pragma unroll 1
      for (int bit = 31; bit >= 0; bit--) {
        unsigned cand = thr | (1u << bit);
        int cnt = 0;
#pragma unroll
        for (int i = 0; i < 16; i++) cnt += (myk[i] >= cand) ? 1 : 0;
        cnt += __shfl_xor(cnt, 1);
        cnt += __shfl_xor(cnt, 2);
        cnt += __shfl_xor(cnt, 4);
        if (cnt >= 16) thr = cand;
      }
      unsigned bits[4] = {0u, 0u, 0u, 0u};
#pragma unroll
      for (int i = 0; i < 16; i++) {
        int j = jg + 8 * i;
        if (myk[i] >= thr && myk[i] != 0u) bits[i >> 2] |= 1u << (jg + 8 * (i & 3));
      }
#pragma unroll
      for (int w = 0; w < 4; w++)
        if (bits[w]) atomicOr(&sSel[q * 4 + w], bits[w]);
    }
    __syncthreads();
#pragma unroll 1
    for (int mode = 1; mode <= 2; mode++) {
      int lo = 0;
      if (mode == 2) {
        lo = q0 - 511;
        if (lo < 0) lo = 0;
        lo >>= 7;
      }
      flash_branch(mode, p.kvbuf + (long)(2 * mode) * partsz + (long)bg * S_ * 64, p.kvbuf + (long)(2 * mode + 1) * partsz + (long)bg * 64 * S_, lo,
                   (q0 + 31) >> 7, qf, t, q0, sSel + qi * 4, mode == 1 ? g1 : g2, outp, sK, sV, lane);
    }
    {
      bf16_t* dst = p.Oattn + tg * 1024 + hq * 64;
#pragma unroll
      for (int di = 0; di < 2; di++)
#pragma unroll
        for (int rq = 0; rq < 4; rq++) {
          int d = di * 32 + rq * 8 + hf * 4;
          *(uint2*)(dst + d) = make_uint2(outp[di][rq * 2], outp[di][rq * 2 + 1]);
        }
    }
  }
}


#define XB_TMO      128
#define XB_XCNT(j)  (256  + 64 * (j))
#define XB_XSUB(j)  (1280 + 64 * (j))
#define XB_XGEN(j)  (2304 + 64 * (j))
#define XB_TOP      3328
#define XB_TOPGEN   3392
#define XCD_BAR_WORDS 3456
#define XB_SPIN_CAP (1u << 22)
#define LAS __attribute__((address_space(3)))
__device__ __forceinline__ unsigned xb_ld(unsigned* p) { return __hip_atomic_load(p, __ATOMIC_RELAXED, __HIP_MEMORY_SCOPE_AGENT); }
__device__ __forceinline__ unsigned xb_add(unsigned* p, unsigned v) { return __hip_atomic_fetch_add(p, v, __ATOMIC_RELAXED, __HIP_MEMORY_SCOPE_AGENT); }
__device__ __forceinline__ unsigned xb_xcc_id() { return (unsigned)__builtin_amdgcn_s_getreg((3 << 11) | 20) & 0xFu; }
#define XB_SPIN(cond, bar) do { unsigned _sp = 0; while (cond) { __builtin_amdgcn_s_sleep(1); \
    if ((++_sp & 255u) == 0u) { if (xb_ld(&(bar)[XB_TMO])) break; if (_sp > XB_SPIN_CAP) { atomicAdd(&(bar)[XB_TMO], 1u); break; } } } } while (0)
struct XcdBarrier { unsigned* bar; unsigned x; volatile LAS unsigned* st; };
__device__ __forceinline__ XcdBarrier xcd_barrier_post(unsigned* bar, volatile LAS unsigned* st) {
  XcdBarrier b; b.bar = bar; b.x = xb_xcc_id(); b.st = st;
  if (threadIdx.x == 0) (void)xb_add(&bar[XB_XCNT(b.x)], 1u);
  return b;
}
__device__ __forceinline__ void xcd_barrier_complete(unsigned* bar, unsigned x, unsigned& nloc, unsigned& nx) {
  const unsigned G = gridDim.x * gridDim.y * gridDim.z;
  unsigned sum, cnt, mine, sp = 0u;
  for (;;) {
    sum = 0u; cnt = 0u; mine = 0u;
#pragma unroll
    for (unsigned j = 0; j < 16; ++j) { const unsigned c = xb_ld(&bar[XB_XCNT(j)]); sum += c; cnt += (c > 0u) ? 1u : 0u; mine = (j == x) ? c : mine; }
    if (sum == G) break;
    __builtin_amdgcn_s_sleep(1);
    if ((++sp & 255u) == 0u) { if (xb_ld(&bar[XB_TMO])) break; if (sp > XB_SPIN_CAP) { atomicAdd(&bar[XB_TMO], 1u); break; } }
  }
  nloc = mine > 0u ? mine : 1u; nx = cnt > 0u ? cnt : 1u;
}
__device__ __forceinline__ void xcd_barrier(const XcdBarrier& b) {
  asm volatile("s_waitcnt vmcnt(0)" ::: "memory");
  __syncthreads();
  if (threadIdx.x == 0) {
    unsigned* bar = b.bar;
    __builtin_amdgcn_s_waitcnt(0);
    unsigned nloc = b.st[0], nx = b.st[1];
    if (nloc == 0u) { xcd_barrier_complete(bar, b.x, nloc, nx); b.st[0] = nloc; b.st[1] = nx; }
    const unsigned old = xb_add(&bar[XB_XSUB(b.x)], 1u);
    const unsigned gen = old / nloc;
    if (old + 1u == (gen + 1u) * nloc) {
      __builtin_amdgcn_fence(__ATOMIC_RELEASE, "agent");
      asm volatile("s_waitcnt vmcnt(0)" ::: "memory");
      const unsigned og = xb_add(&bar[XB_TOP], 1u);
      const unsigned tg = og / nx;
      if (og + 1u == (tg + 1u) * nx) xb_add(&bar[XB_TOPGEN], 1u);
      else XB_SPIN(xb_ld(&bar[XB_TOPGEN]) == tg, bar);
      __builtin_amdgcn_fence(__ATOMIC_ACQUIRE, "agent");
      xb_add(&bar[XB_XGEN(b.x)], 1u);
      asm volatile("s_waitcnt vmcnt(0)" ::: "memory");
    } else {
      XB_SPIN(xb_ld(&bar[XB_XGEN(b.x)]) == gen, bar);
      __builtin_amdgcn_fence(__ATOMIC_ACQUIRE, "agent");
      asm volatile("s_waitcnt vmcnt(0)" ::: "memory");
    }
  }
  __syncthreads();
}

__global__ void __launch_bounds__(256, 2) mk(P p, int lo, int hi) {
  __shared__ __attribute__((aligned(16))) unsigned char smem[SMEM_BYTES];
  cg::grid_group grid = cg::this_grid();
  __shared__ uint4 xb_words;
  if (threadIdx.x == 0) xb_words = make_uint4(0u, 0u, 0u, 0u);
  __syncthreads();
  const XcdBarrier xb = xcd_barrier_post(p.bar, (volatile LAS unsigned*)&xb_words);
  int ph = 0;
#define RUN(stmt)                                   \
  {                                                 \
    if (ph >= lo && ph < hi) { stmt; }              \
    ph++;                                           \
    if (ph > lo && ph < hi) {                       \
      if (lo < 0) grid.sync();   xcd_barrier(xb); \
    }                                               \
  }
#define RUNX(id, stmt)                                           \
  {                                                              \
    if (ph >= lo && ph < hi) { stmt; if (PROBE_ID == id) { stmt; } } \
    ph++;                                                        \
    if (ph > lo && ph < hi) {                                    \
      if (lo < 0) grid.sync();   xcd_barrier(xb);            \
    }                                                            \
  }
  RUNX(1, prep_phase(p, smem));
  RUNX(2, h0_phase(p));
  for (int layer = 0; layer < 4; layer++) {
    if (layer < 2) {
      RUNX(3, ret_proj_phase(p, layer, smem));
      RUNX(4, ret_up_phase(p, smem));
      RUN(ret_scan_phase(p));
      RUNX(6, ret_out_phase(p, smem));
      RUN(ret_gn_phase(p));
      RUN(wo_phase(p, layer, p.Gs, p.retWoT + (long)layer * 1024 * 2048, 2048, smem));
    } else {
      if (layer == 3) { RUNX(16, nsa_q_phase(p, 1, smem)); }
      RUNX(17, nsa_attn_phase(p, smem));
      RUN(wo_phase(p, layer, p.Oattn, p.nsaWoT + (long)(layer - 2) * 1024 * 1024, 1024, smem));
    }
    RUN(ln1_phase(p, layer));
    RUNX(10, peer_qscore_phase(p, layer, smem));
    {
      if (PROBE_ID == 12 && ph >= lo && ph < hi) peer_expert_phase(p, layer, smem, true);
      RUN(peer_expert_phase(p, layer, smem, false));
    }
    if (layer == 1) {
      RUNX(13, kv_proj_phase(p, smem));
      RUN({ cmp1_phase(p, smem); nsa_q_phase(p, 0, smem); });
      RUNX(15, cmp2_phase(p, smem));
    }
  }
}
#define NPHASES (2 + 2 * 6 + 5 + 4 * 3 + 3)

extern "C" void kernel_launch(void* const* d_in, const int* in_sizes, int n_in, void* d_out, int out_size, void* d_ws,
                              size_t ws_size, hipStream_t stream) {
  static int grid_blocks = 0;
  if (!grid_blocks) {
    int dev = 0, cus = 0, per_cu = 0;
    hipGetDevice(&dev);
    hipDeviceGetAttribute(&cus, hipDeviceAttributeMultiprocessorCount, dev);
    hipOccupancyMaxActiveBlocksPerMultiprocessor(&per_cu, mk, 256, 0);
    if (per_cu > 2) per_cu = 2;
    if (per_cu < 1) per_cu = 1;
    grid_blocks = cus * per_cu;
  }
  P p{};
  const float** fin = (const float**)&p;
  for (int i = 0; i < 21; i++) fin[i] = (const float*)d_in[i];
  p.out = (float*)d_out;
  size_t off = 0;
  auto alloc = [&](size_t bytes) {
    void* r = (char*)d_ws + off;
    off += (bytes + 255) & ~(size_t)255;
    return r;
  };
  p.retWinT = (bf16_t*)alloc(2UL * 6144 * 1024 * 2);
  p.retWoT = (bf16_t*)alloc(2UL * 1024 * 2048 * 2);
  p.kvWT = (bf16_t*)alloc(1536UL * 1024 * 2);
  p.w1T = (bf16_t*)alloc(2UL * 256 * 2048 * 2);
  p.w2T = (bf16_t*)alloc(2UL * 128 * 256 * 2);
  p.nsaWinT = (bf16_t*)alloc(2UL * 1152 * 1024 * 2);
  p.nsaWoT = (bf16_t*)alloc(2UL * 1024 * 1024 * 2);
  p.wqT = (bf16_t*)alloc(4UL * 2048 * 1024 * 2);
  p.keysB = (bf16_t*)alloc(4UL * 16 * 128 * 128 * 2);
  p.uB = (unsigned char*)alloc(4UL * 16384 * 2048);
  p.vB = p.uB + 1024;
  p.su = (float*)alloc(4UL * 16384 * 4);
  p.sv = (float*)alloc(4UL * 16384 * 4);
  p.mods = (float*)alloc(4UL * 2 * 6144 * 4);
  p.kvmod = (float*)alloc(2UL * 2048 * 4);
  p.cs = (float*)alloc(8192UL * 128 * 2 * 4);
  p.biasp = (float*)alloc(512 * 4);
  p.bar = (unsigned*)alloc(XCD_BAR_WORDS * 4);
  p.xbuf = (float*)alloc((size_t)T_ * 1024 * 4);
  p.hbuf = (bf16_t*)alloc((size_t)T_ * 1024 * 2);
  p.xsbuf = (bf16_t*)alloc((size_t)T_ * 1024 * 2);
  p.kvbuf = (bf16_t*)alloc(6UL * 8 * S_ * 64 * 2 + 65536);
  p.Kc = (bf16_t*)alloc(8UL * 512 * 64 * 2);
  p.VcT = (bf16_t*)alloc(8UL * 64 * 512 * 2);
  size_t arena = off;
  p.Qd = (bf16_t*)alloc(8UL * S_ * 256 * 2);
  p.Kd = (bf16_t*)alloc(8UL * S_ * 256 * 2);
  p.KdT = (bf16_t*)alloc(8UL * 256 * S_ * 2);
  p.VT = (bf16_t*)alloc(8UL * 512 * S_ * 2);
  p.Gs = (bf16_t*)alloc((size_t)T_ * 2048 * 2);
  p.ST = (bf16_t*)alloc(8UL * 64 * 512 * 256 * 2);
  p.Pb = (bf16_t*)alloc(8UL * 64 * 128 * 128 * 2);
  p.Ob = (bf16_t*)alloc((size_t)T_ * 2048 * 2);
  size_t end_ret = off;
  off = arena;
  p.qp = (bf16_t*)alloc((size_t)T_ * 2048 * 2);
  p.topk = (int*)alloc((size_t)T_ * 16 * 16 * 4);
  p.Qn = (bf16_t*)alloc((size_t)T_ * 1024 * 2);
  p.gate = (float*)alloc((size_t)T_ * 48 * 4);
  p.Oattn = (bf16_t*)alloc((size_t)T_ * 1024 * 2);
  p.hid = (bf16_t*)alloc(16UL * 512 * 256 * 2);
  size_t end_other = off;
  size_t need = end_ret > end_other ? end_ret : end_other;
  if (need > ws_size) {
    fprintf(stderr, "workspace too small: need %zu have %zu\n", need, ws_size);
    return;
  }
#if MULTI_LAUNCH
  for (int ph = 0; ph < NPHASES; ph++) {
    hipLaunchKernelGGL(mk, dim3(grid_blocks), dim3(256), 0, stream, p, ph, ph + 1);
  }
#else
  hipMemsetAsync(p.bar, 0, XCD_BAR_WORDS * 4, stream);
  int lo = 0, hi = NPHASES;
  void* args[] = {&p, &lo, &hi};
  hipError_t e = hipLaunchCooperativeKernel((void*)mk, dim3(grid_blocks), dim3(256), args, 0, stream);
  if (e != hipSuccess) fprintf(stderr, "cooperative launch failed: %s (grid %d)\n", hipGetErrorString(e), grid_blocks);
#endif
}
```

```cpp
#include <hip/hip_runtime.h>
#include <hip/hip_cooperative_groups.h>
#include <cstdio>
#include <cstdint>
namespace cg = cooperative_groups;

typedef unsigned short bf16_t;
typedef short bf16x8 __attribute__((ext_vector_type(8)));
typedef float f32x16 __attribute__((ext_vector_type(16)));
typedef float f32x2 __attribute__((ext_vector_type(2)));

#ifndef PROBE_ID
#define PROBE_ID 0
#endif
#ifndef MULTI_LAUNCH
#define MULTI_LAUNCH 0
#endif

#define T_ 16384
#define S_ 8192
#define D_ 1024
#define ALPHA_ 1.681792830507429f
#define LN_EPS_ 1e-5f
#define SMEM_BYTES 73728
#define LSTR 72

struct P {
  const float *x, *c, *ada_w, *ada_b, *ln_g, *ln_b, *ret_w_in, *ret_w_o, *kv_ada_w, *kv_ada_b, *nsa_w_kv,
      *cmp_pe, *cmp_w1, *cmp_b1, *cmp_w2, *nsa_w_in, *nsa_w_o, *peer_w_q, *peer_keys, *peer_u, *peer_v;
  float* out;
  bf16_t *retWinT, *retWoT, *kvWT, *w1T, *w2T, *nsaWinT, *nsaWoT, *wqT, *keysB;
  unsigned char *uB, *vB;
  float *su, *sv;
  float *mods, *kvmod, *cs, *biasp;
  float* xbuf;
  bf16_t *hbuf, *xsbuf;
  bf16_t *kvbuf, *hid, *Kc, *VcT;
  bf16_t *Qd, *Kd, *KdT, *VT, *Gs, *ST, *Pb, *Ob;
  bf16_t* qp;
  int* topk;
  bf16_t* Qn;
  float* gate;
  bf16_t* Oattn;
  unsigned* bar;
};

__device__ __forceinline__ int otid() {
  int t = threadIdx.x;
  asm volatile("" : "+v"(t));
  return t;
}
__device__ __forceinline__ float bf2f(bf16_t b) { return __uint_as_float(((unsigned)b) << 16); }
__device__ __forceinline__ bf16_t f2bf(float f) {
  unsigned u = __float_as_uint(f);
  u += 0x7fffu + ((u >> 16) & 1u);
  return (bf16_t)(u >> 16);
}
typedef __bf16 bf16x2_t __attribute__((ext_vector_type(2)));
__device__ __forceinline__ unsigned pack2(float a, float b) {
  f32x2 v = {a, b};
  bf16x2_t r = __builtin_convertvector(v, bf16x2_t);
  return __builtin_bit_cast(unsigned, r);
}
__device__ __forceinline__ float ex2(float x) { return __builtin_amdgcn_exp2f(x); }
__device__ __forceinline__ float gelu_t(float x) {
  float u = 0.7978845608028654f * (x + 0.044715f * x * x * x);
  return x / (1.f + __expf(-2.f * u));
}
__device__ __forceinline__ float silu_f(float x) { return x / (1.f + __expf(-x)); }
__device__ __forceinline__ float sigmoid_f(float x) { return 1.f / (1.f + __expf(-x)); }
__device__ __forceinline__ float wave_allsum(float v) {
#pragma unroll
  for (int o = 32; o >= 1; o >>= 1) v += __shfl_xor(v, o);
  return v;
}
__device__ __forceinline__ f32x16 mfma32(bf16x8 a, bf16x8 b, f32x16 c) {
  return __builtin_amdgcn_mfma_f32_32x32x16_bf16(a, b, c, 0, 0, 0);
}

__device__ __forceinline__ void gemm_tile(const bf16_t* __restrict__ A, long lda, const bf16_t* __restrict__ B, long ldb,
                                          int K, f32x16 (&acc)[2][2], unsigned char* smem) {
  const int tid = otid(), lane = tid & 63, wave = tid >> 6;
  const int wm = wave >> 1, wn = wave & 1;
  const int lr = tid >> 3, lc = (tid & 7) * 8;
  bf16_t* sA = (bf16_t*)smem;
  bf16_t* sB = sA + 2 * 128 * LSTR;
  const bf16_t* Ap = A + (long)lr * lda + lc;
  const bf16_t* Bp = B + (long)lr * ldb + lc;
  uint4 ra0_0, ra0_1, ra0_2, ra0_3, rb0_0, rb0_1, rb0_2, rb0_3, ra1_0, ra1_1, ra1_2, ra1_3, rb1_0, rb1_1, rb1_2, rb1_3;
  const int nk = K >> 6;
#define G_LOAD1(RA, RB, KT, i)                                        \
  RA##_##i = *(const uint4*)(Ap + (long)(i * 32) * lda + (KT) * 64);       \
  RB##_##i = *(const uint4*)(Bp + (long)(i * 32) * ldb + (KT) * 64);
#define G_LOAD(RA, RB, KT) G_LOAD1(RA, RB, KT, 0) G_LOAD1(RA, RB, KT, 1) G_LOAD1(RA, RB, KT, 2) G_LOAD1(RA, RB, KT, 3)
#define G_STORE1(RA, RB, BUF, i)                                                  \
  *(uint4*)(sA + (BUF) * 128 * LSTR + (lr + i * 32) * LSTR + lc) = RA##_##i;         \
  *(uint4*)(sB + (BUF) * 128 * LSTR + (lr + i * 32) * LSTR + lc) = RB##_##i;
#define G_STORE(RA, RB, BUF) G_STORE1(RA, RB, BUF, 0) G_STORE1(RA, RB, BUF, 1) G_STORE1(RA, RB, BUF, 2) G_STORE1(RA, RB, BUF, 3)
#define G_CK(BUF, kk)                                                                                       \
  {                                                                                                         \
    bf16x8 a0 = *(const bf16x8*)(a_s + (BUF) * 128 * LSTR + kk * 16);                                       \
    bf16x8 a1 = *(const bf16x8*)(a_s + (BUF) * 128 * LSTR + 32 * LSTR + kk * 16);                           \
    bf16x8 b0 = *(const bf16x8*)(b_s + (BUF) * 128 * LSTR + kk * 16);                                       \
    bf16x8 b1 = *(const bf16x8*)(b_s + (BUF) * 128 * LSTR + 64 * LSTR + kk * 16);                           \
    acc[0][0] = mfma32(a0, b0, acc[0][0]);                                                                  \
    acc[0][1] = mfma32(a0, b1, acc[0][1]);                                                                  \
    acc[1][0] = mfma32(a1, b0, acc[1][0]);                                                                  \
    acc[1][1] = mfma32(a1, b1, acc[1][1]);                                                                  \
  }
#define G_COMPUTE(BUF) G_CK(BUF, 0) G_CK(BUF, 1) G_CK(BUF, 2) G_CK(BUF, 3)
  const bf16_t* a_s = sA + (wm * 64 + (lane & 31)) * LSTR + (lane >> 5) * 8;
  const bf16_t* b_s = sB + (wn * 32 + (lane & 31)) * LSTR + (lane >> 5) * 8;
  __syncthreads();
  G_LOAD(ra0, rb0, 0);
  G_LOAD(ra1, rb1, 1);
  G_STORE(ra0, rb0, 0);
  __syncthreads();
#pragma unroll 1
  for (int kt = 0; kt < nk; kt += 2) {
    if (kt + 2 < nk) { G_LOAD(ra0, rb0, kt + 2); }
    G_COMPUTE(0);
    G_STORE(ra1, rb1, 1);
    __syncthreads();
    if (kt + 3 < nk) { G_LOAD(ra1, rb1, kt + 3); }
    G_COMPUTE(1);
    if (kt + 2 < nk) { G_STORE(ra0, rb0, 0); }
    __syncthreads();
  }
#undef G_LOAD
#undef G_LOAD1
#undef G_STORE
#undef G_STORE1
#undef G_COMPUTE
#undef G_CK
}

__device__ __forceinline__ void gemm_tile_w41(const bf16_t* __restrict__ A, long lda, const bf16_t* __restrict__ B, long ldb,
                                              int K, f32x16 (&acc)[4], unsigned char* smem) {
  const int tid = otid(), lane = tid & 63, wave = tid >> 6;
  const int lr = tid >> 3, lc = (tid & 7) * 8;
  bf16_t* sA = (bf16_t*)smem;
  bf16_t* sB = sA + 2 * 128 * LSTR;
  const bf16_t* Ap = A + (long)lr * lda + lc;
  const bf16_t* Bp = B + (long)lr * ldb + lc;
  uint4 ra0_0, ra0_1, ra0_2, ra0_3, rb0_0, rb0_1, rb0_2, rb0_3, ra1_0, ra1_1, ra1_2, ra1_3, rb1_0, rb1_1, rb1_2, rb1_3;
  const int nk = K >> 6;
#define G_LOAD1(RA, RB, KT, i)                                        \
  RA##_##i = *(const uint4*)(Ap + (long)(i * 32) * lda + (KT) * 64);  \
  RB##_##i = *(const uint4*)(Bp + (long)(i * 32) * ldb + (KT) * 64);
#define G_LOAD(RA, RB, KT) G_LOAD1(RA, RB, KT, 0) G_LOAD1(RA, RB, KT, 1) G_LOAD1(RA, RB, KT, 2) G_LOAD1(RA, RB, KT, 3)
#define G_STORE1(RA, RB, BUF, i)                                                  \
  *(uint4*)(sA + (BUF) * 128 * LSTR + (lr + i * 32) * LSTR + lc) = RA##_##i;      \
  *(uint4*)(sB + (BUF) * 128 * LSTR + (lr + i * 32) * LSTR + lc) = RB##_##i;
#define G_STORE(RA, RB, BUF) G_STORE1(RA, RB, BUF, 0) G_STORE1(RA, RB, BUF, 1) G_STORE1(RA, RB, BUF, 2) G_STORE1(RA, RB, BUF, 3)
#define G_CK(BUF, kk)                                                                         \
  {                                                                                           \
    bf16x8 b0 = *(const bf16x8*)(b_s + (BUF) * 128 * LSTR + kk * 16);                         \
    bf16x8 a0 = *(const bf16x8*)(a_s + (BUF) * 128 * LSTR + kk * 16);                         \
    bf16x8 a1 = *(const bf16x8*)(a_s + (BUF) * 128 * LSTR + 32 * LSTR + kk * 16);             \
    bf16x8 a2 = *(const bf16x8*)(a_s + (BUF) * 128 * LSTR + 64 * LSTR + kk * 16);             \
    bf16x8 a3 = *(const bf16x8*)(a_s + (BUF) * 128 * LSTR + 96 * LSTR + kk * 16);             \
    acc[0] = mfma32(a0, b0, acc[0]);                                                          \
    acc[1] = mfma32(a1, b0, acc[1]);                                                          \
    acc[2] = mfma32(a2, b0, acc[2]);                                                          \
    acc[3] = mfma32(a3, b0, acc[3]);                                                          \
  }
#define G_COMPUTE(BUF) G_CK(BUF, 0) G_CK(BUF, 1) G_CK(BUF, 2) G_CK(BUF, 3)
  const bf16_t* a_s = sA + (lane & 31) * LSTR + (lane >> 5) * 8;
  const bf16_t* b_s = sB + (wave * 32 + (lane & 31)) * LSTR + (lane >> 5) * 8;
  __syncthreads();
  G_LOAD(ra0, rb0, 0);
  G_LOAD(ra1, rb1, 1);
  G_STORE(ra0, rb0, 0);
  __syncthreads();
#pragma unroll 1
  for (int kt = 0; kt < nk; kt += 2) {
    if (kt + 2 < nk) { G_LOAD(ra0, rb0, kt + 2); }
    G_COMPUTE(0);
    G_STORE(ra1, rb1, 1);
    __syncthreads();
    if (kt + 3 < nk) { G_LOAD(ra1, rb1, kt + 3); }
    G_COMPUTE(1);
    if (kt + 2 < nk) { G_STORE(ra0, rb0, 0); }
    __syncthreads();
  }
#undef G_LOAD
#undef G_LOAD1
#undef G_STORE
#undef G_STORE1
#undef G_COMPUTE
#undef G_CK
}

__device__ __forceinline__ void gemm_tile256(const bf16_t* __restrict__ A, long lda, const bf16_t* __restrict__ B, long ldb,
                                             int K, f32x16 (&acc)[2][4], unsigned char* smem) {
  const int tid = otid(), lane = tid & 63, wave = tid >> 6;
  const int lr = tid >> 3, lc = (tid & 7) * 8;
  bf16_t* sA = (bf16_t*)smem;
  bf16_t* sB = sA + 256 * LSTR;
  const bf16_t* Ap = A + (long)lr * lda + lc;
  const bf16_t* Bp = B + (long)lr * ldb + lc;
  uint4 a_0, a_1, a_2, a_3, a_4, a_5, a_6, a_7, b_0, b_1, b_2, b_3;
  const int nk = K >> 6;
#define H_LA(i, KT) a_##i = *(const uint4*)(Ap + (long)(i * 32) * lda + (KT) * 64);
#define H_LB(i, KT) b_##i = *(const uint4*)(Bp + (long)(i * 32) * ldb + (KT) * 64);
#define H_LOAD(KT) H_LA(0, KT) H_LA(1, KT) H_LA(2, KT) H_LA(3, KT) H_LA(4, KT) H_LA(5, KT) H_LA(6, KT) H_LA(7, KT) H_LB(0, KT) H_LB(1, KT) H_LB(2, KT) H_LB(3, KT)
#define H_SA(i) *(uint4*)(sA + (lr + i * 32) * LSTR + lc) = a_##i;
#define H_SB(i) *(uint4*)(sB + (lr + i * 32) * LSTR + lc) = b_##i;
#define H_STORE() H_SA(0) H_SA(1) H_SA(2) H_SA(3) H_SA(4) H_SA(5) H_SA(6) H_SA(7) H_SB(0) H_SB(1) H_SB(2) H_SB(3)
  const bf16_t* a_s = sA + (wave * 64 + (lane & 31)) * LSTR + (lane >> 5) * 8;
  const bf16_t* b_s = sB + (lane & 31) * LSTR + (lane >> 5) * 8;
  H_LOAD(0);
#pragma unroll 1
  for (int kt = 0; kt < nk; kt++) {
    __syncthreads();
    H_STORE();
    __syncthreads();
    const int kn = (kt + 1 < nk) ? kt + 1 : kt;
    H_LOAD(kn);
    __builtin_amdgcn_sched_barrier(0);
#pragma unroll
    for (int kk = 0; kk < 4; kk++) {
      bf16x8 fa0 = *(const bf16x8*)(a_s + kk * 16);
      bf16x8 fa1 = *(const bf16x8*)(a_s + 32 * LSTR + kk * 16);
      bf16x8 fb0 = *(const bf16x8*)(b_s + kk * 16);
      bf16x8 fb1 = *(const bf16x8*)(b_s + 32 * LSTR + kk * 16);
      bf16x8 fb2 = *(const bf16x8*)(b_s + 64 * LSTR + kk * 16);
      bf16x8 fb3 = *(const bf16x8*)(b_s + 96 * LSTR + kk * 16);
      acc[0][0] = mfma32(fa0, fb0, acc[0][0]);
      acc[0][1] = mfma32(fa0, fb1, acc[0][1]);
      acc[0][2] = mfma32(fa0, fb2, acc[0][2]);
      acc[0][3] = mfma32(fa0, fb3, acc[0][3]);
      acc[1][0] = mfma32(fa1, fb0, acc[1][0]);
      acc[1][1] = mfma32(fa1, fb1, acc[1][1]);
      acc[1][2] = mfma32(fa1, fb2, acc[1][2]);
      acc[1][3] = mfma32(fa1, fb3, acc[1][3]);
    }
  }
  __syncthreads();
#undef H_LA
#undef H_LB
#undef H_LOAD
#undef H_SA
#undef H_SB
#undef H_STORE
}
template <class F>
__device__ __forceinline__ void epi_pairs256(const f32x16 (&acc)[2][4], F f) {
  const int tid_ = otid();
  const int lane = tid_ & 63, wave = tid_ >> 6;
#pragma unroll
  for (int mi = 0; mi < 2; mi++)
#pragma unroll
    for (int np = 0; np < 2; np++)
#pragma unroll
      for (int rq = 0; rq < 4; rq++) {
        int row0 = wave * 64 + mi * 32 + rq * 8 + (lane >> 5) * 4;
        int col0 = np * 32 + (lane & 31);
        float v0[4], v1[4];
#pragma unroll
        for (int j = 0; j < 4; j++) {
          v0[j] = acc[mi][np][rq * 4 + j];
          v1[j] = acc[mi][np + 2][rq * 4 + j];
        }
        f(row0, col0, v0, v1);
      }
}

__device__ __forceinline__ void tile_map(int it, int ntm, int ntn, int mode, int& tm, int& tn) {
  const int G = gridDim.x, total = ntm * ntn;
  const int r = it / G, b = it - r * G;
  int t2 = it;
  if ((G & 63) == 0 && (r + 1) * G <= total) {
    const int xcd = b & 7, j = b >> 3, cpx = G >> 3;
    if (mode == 1) {
      t2 = r * G + xcd * cpx + j;
    } else if (mode == 2 && cpx == 64 && (ntn & 7) == 0 && (ntm & 7) == 0) {
      const int q = r * 8 + xcd, npn = ntn >> 3;
      const int qm = q / npn, qn = q - qm * npn;
      tm = qm * 8 + (j >> 3);
      tn = qn * 8 + (j & 7);
      return;
    }
  }
  tn = t2 % ntn;
  tm = t2 / ntn;
}

__device__ __forceinline__ int item_swz(int it, int total) {
  const int G = gridDim.x;
  const int r = it / G, b = it - r * G;
  if ((G & 7) == 0 && (r + 1) * G <= total) return r * G + (b & 7) * (G >> 3) + (b >> 3);
  return it;
}
__device__ __forceinline__ void zero_acc(f32x16 (&acc)[2][2]) {
#pragma unroll
  for (int i = 0; i < 2; i++)
#pragma unroll
    for (int j = 0; j < 2; j++)
#pragma unroll
      for (int r = 0; r < 16; r++) acc[i][j][r] = 0.f;
}

template <class F>
__device__ __forceinline__ void epi_pairs(const f32x16 (&acc)[2][2], F f) {
  const int tid_ = otid(); const int lane = tid_ & 63, wave = tid_ >> 6, wm = wave >> 1, wn = wave & 1;
#pragma unroll
  for (int mi = 0; mi < 2; mi++)
#pragma unroll
    for (int rq = 0; rq < 4; rq++) {
      int row0 = wm * 64 + mi * 32 + rq * 8 + (lane >> 5) * 4;
      int col0 = wn * 32 + (lane & 31);
      float v0[4], v1[4];
#pragma unroll
      for (int j = 0; j < 4; j++) {
        v0[j] = acc[mi][0][rq * 4 + j];
        v1[j] = acc[mi][1][rq * 4 + j];
      }
      f(row0, col0, v0, v1);
    }
}

__device__ __forceinline__ void transpose_job(const float* __restrict__ src, int K, int N, bf16_t* __restrict__ dst, int Npad, int perm,
                              unsigned char* smem) {
  float* t = (float*)smem;
  const int tid = otid();
  const int tilesN = Npad / 64, tilesK = K / 64;
  for (int it = blockIdx.x; it < tilesN * tilesK; it += gridDim.x) {
    int tn = it % tilesN, tk = it / tilesN;
    int n0 = tn * 64, k0 = tk * 64;
    int sn0 = n0;
    if (perm && n0 < 2048) {
      int hd = n0 >> 8, t2 = (n0 >> 7) & 1, half = (n0 >> 6) & 1;
      sn0 = hd * 256 + half * 128 + t2 * 64;
    }
    __syncthreads();
    {
      int kk = tid >> 2;
#pragma unroll
      for (int j = 0; j < 4; j++) {
        int cc = (tid & 3) * 16 + j * 4;
        float4 v = make_float4(0.f, 0.f, 0.f, 0.f);
        if (sn0 + cc < N) v = *(const float4*)(src + (long)(k0 + kk) * N + sn0 + cc);
        t[(cc + 0) * 65 + kk] = v.x;
        t[(cc + 1) * 65 + kk] = v.y;
        t[(cc + 2) * 65 + kk] = v.z;
        t[(cc + 3) * 65 + kk] = v.w;
      }
    }
    __syncthreads();
    {
      int n = tid >> 2, kc = (tid & 3) * 16;
      unsigned w[8];
#pragma unroll
      for (int j = 0; j < 8; j++) w[j] = pack2(t[n * 65 + kc + 2 * j], t[n * 65 + kc + 2 * j + 1]);
      uint4* d = (uint4*)(dst + (long)(n0 + n) * K + k0 + kc);
      d[0] = make_uint4(w[0], w[1], w[2], w[3]);
      d[1] = make_uint4(w[4], w[5], w[6], w[7]);
    }
  }
}

__device__ __forceinline__ void convert_job(const float* __restrict__ src, bf16_t* __restrict__ dst, long n) {
  long i = ((long)blockIdx.x * 256 + otid()) * 8;
  long stride = (long)gridDim.x * 256 * 8;
  for (; i < n; i += stride) {
    float4 a = *(const float4*)(src + i), b = *(const float4*)(src + i + 4);
    *(uint4*)(dst + i) = make_uint4(pack2(a.x, a.y), pack2(a.z, a.w), pack2(b.x, b.y), pack2(b.z, b.w));
  }
}


__device__ __forceinline__ float dpp_rowsum(float v) {
  v += __int_as_float(__builtin_amdgcn_update_dpp(0, __float_as_int(v), 0xB1, 0xF, 0xF, true));
  v += __int_as_float(__builtin_amdgcn_update_dpp(0, __float_as_int(v), 0x4E, 0xF, 0xF, true));
  v += __int_as_float(__builtin_amdgcn_update_dpp(0, __float_as_int(v), 0x141, 0xF, 0xF, true));
  v += __int_as_float(__builtin_amdgcn_update_dpp(0, __float_as_int(v), 0x140, 0xF, 0xF, true));
  return v;
}
__device__ __forceinline__ float wave_allsum_fast(float v) {
  v = dpp_rowsum(v);
  float s0 = __int_as_float(__builtin_amdgcn_readlane(__float_as_int(v), 0));
  float s1 = __int_as_float(__builtin_amdgcn_readlane(__float_as_int(v), 16));
  float s2 = __int_as_float(__builtin_amdgcn_readlane(__float_as_int(v), 32));
  float s3 = __int_as_float(__builtin_amdgcn_readlane(__float_as_int(v), 48));
  return (s0 + s1) + (s2 + s3);
}
__device__ __forceinline__ void convert_fp8_job(const float* __restrict__ src, unsigned char* __restrict__ dst, float* __restrict__ inv_scale, int rows) {
  const int tid = otid(), lane = tid & 63, wave = tid >> 6;
  for (int r = blockIdx.x * 4 + wave; r < rows; r += gridDim.x * 4) {
    const float* sr = src + (long)r * 1024;
    float v[16];
#pragma unroll
    for (int j = 0; j < 2; j++) {
      float4 a = *(const float4*)(sr + j * 512 + lane * 8), b = *(const float4*)(sr + j * 512 + lane * 8 + 4);
      v[j * 8 + 0] = a.x; v[j * 8 + 1] = a.y; v[j * 8 + 2] = a.z; v[j * 8 + 3] = a.w;
      v[j * 8 + 4] = b.x; v[j * 8 + 5] = b.y; v[j * 8 + 6] = b.z; v[j * 8 + 7] = b.w;
    }
    float mx = 0.f;
#pragma unroll
    for (int i = 0; i < 16; i++) mx = fmaxf(mx, fabsf(v[i]));
#pragma unroll
    for (int o = 32; o >= 1; o >>= 1) mx = fmaxf(mx, __shfl_xor(mx, o));
    mx = fmaxf(mx, 1e-20f);
    float sc = 384.f / mx;
    int w[4];
#pragma unroll
    for (int q = 0; q < 4; q++) {
      int x = 0;
      x = __builtin_amdgcn_cvt_pk_fp8_f32(v[q * 4 + 0] * sc, v[q * 4 + 1] * sc, x, false);
      x = __builtin_amdgcn_cvt_pk_fp8_f32(v[q * 4 + 2] * sc, v[q * 4 + 3] * sc, x, true);
      w[q] = x;
    }
    *(int4*)(dst + (long)r * 2048 + lane * 16) = make_int4(w[0], w[1], w[2], w[3]);
    if (lane == 0) inv_scale[r] = mx * (1.f / 384.f);
  }
}

__device__ __forceinline__ void modvec_job(const float* __restrict__ c, const float* __restrict__ W, const float* __restrict__ bias,
                           float* __restrict__ out, int N, int item0, int nitems_total_before, unsigned char* smem) {
}

__device__ __forceinline__ void prep_phase(const P& p, unsigned char* smem) {
  for (int l = 0; l < 2; l++) {
    transpose_job(p.ret_w_in + (long)l * 1024 * 6144, 1024, 6144, p.retWinT + (long)l * 6144 * 1024, 6144, 1, smem);
    transpose_job(p.ret_w_o + (long)l * 2048 * 1024, 2048, 1024, p.retWoT + (long)l * 1024 * 2048, 1024, 0, smem);
    transpose_job(p.cmp_w1 + (long)l * 2048 * 256, 2048, 256, p.w1T + (long)l * 256 * 2048, 256, 0, smem);
    transpose_job(p.cmp_w2 + (long)l * 256 * 64, 256, 64, p.w2T + (long)l * 128 * 256, 128, 0, smem);
    transpose_job(p.nsa_w_in + (long)l * 1024 * 1072, 1024, 1072, p.nsaWinT + (long)l * 1152 * 1024, 1152, 0, smem);
    transpose_job(p.nsa_w_o + (long)l * 1024 * 1024, 1024, 1024, p.nsaWoT + (long)l * 1024 * 1024, 1024, 0, smem);
  }
  transpose_job(p.nsa_w_kv, 1024, 1536, p.kvWT, 1536, 0, smem);
  for (int l = 0; l < 4; l++)
    transpose_job(p.peer_w_q + (long)l * 1024 * 2048, 1024, 2048, p.wqT + (long)l * 2048 * 1024, 2048, 0, smem);
  convert_job(p.peer_keys, p.keysB, 4L * 8 * 2 * 128 * 128);
  convert_fp8_job(p.peer_u, p.uB, p.su, 4 * 16384);
  convert_fp8_job(p.peer_v, p.uB + 1024, p.sv, 4 * 16384);
  {
    __syncthreads();
    float* red = (float*)smem;
    float* sc_ = (float*)smem + 512;
    const int tid = otid(), lane = tid & 63, wave = tid >> 6;
    for (int i = tid; i < 2048; i += 256) sc_[i] = silu_f(p.c[i]);
    __syncthreads();
    const int nitems = (4 * 6144 + 2048) / 64;
    for (int it = blockIdx.x; it < nitems; it += gridDim.x) {
      int col = it * 64 + lane;
      const float* W;
      const float* bias;
      float* out;
      int N, n;
      if (col < 4 * 6144) {
        int l = col / 6144;
        n = col % 6144;
        W = p.ada_w + (long)l * 1024 * 6144;
        bias = p.ada_b + l * 6144;
        out = p.mods + l * 2 * 6144;
        N = 6144;
      } else {
        n = col - 4 * 6144;
        W = p.kv_ada_w;
        bias = p.kv_ada_b;
        out = p.kvmod;
        N = 2048;
      }
      float a0 = 0.f, a1 = 0.f;
      const float* wp = W + (long)(wave * 256) * N + n;
      const float* c0 = sc_ + wave * 256;
      for (int k = 0; k < 256; k += 16) {
        float w[16];
#pragma unroll
        for (int u = 0; u < 16; u++) w[u] = wp[(long)(k + u) * N];
#pragma unroll
        for (int u = 0; u < 16; u++) {
          a0 += c0[k + u] * w[u];
          a1 += c0[1024 + k + u] * w[u];
        }
      }
      __syncthreads();
      red[(wave * 2 + 0) * 64 + lane] = a0;
      red[(wave * 2 + 1) * 64 + lane] = a1;
      __syncthreads();
      if (wave < 2) {
        float sm = bias[n];
        for (int w = 0; w < 4; w++) sm += red[(w * 2 + wave) * 64 + lane];
        out[wave * N + n] = sm;
      }
    }
  }
  {
    long n = 8192L * 128;
    for (long i = (long)blockIdx.x * 256 + otid(); i < n; i += (long)gridDim.x * 256) {
      int s = (int)(i >> 7), fi = (int)(i & 127);
      float theta = 1.0f / powf(10000.0f, (float)fi / 127.0f);
      float ang = (float)s * theta;
      float sn, cn;
      sincosf(ang, &sn, &cn);
      p.cs[2 * i] = cn;
      p.cs[2 * i + 1] = sn;
    }
  }
  {
    const int tid = otid(), lane = tid & 63, wave = tid >> 6;
    for (int o = blockIdx.x * 4 + wave; o < 512; o += gridDim.x * 4) {
      int c = o >> 8, j = o & 255;
      float sm = 0.f;
      for (int f = lane; f < 2048; f += 64) sm += p.cmp_pe[c * 2048 + f] * p.cmp_w1[((long)c * 2048 + f) * 256 + j];
      sm = wave_allsum(sm);
      if (lane == 0) p.biasp[o] = sm + p.cmp_b1[c * 256 + j];
    }
  }
}

__device__ __forceinline__ void h0_phase(const P& p) {
  long n = (long)T_ * D_;
  for (long i = ((long)blockIdx.x * 256 + otid()) * 8; i < n; i += (long)gridDim.x * 256 * 8) {
    int t = (int)(i >> 10), k = (int)(i & 1023);
    int b = t / S_;
    const float* md = p.mods + b * 6144;
    float4 a = *(const float4*)(p.x + i), bb = *(const float4*)(p.x + i + 4);
    float xv[8] = {a.x, a.y, a.z, a.w, bb.x, bb.y, bb.z, bb.w};
    float h[8];
#pragma unroll
    for (int j = 0; j < 8; j++) h[j] = xv[j] * (1.f + md[1024 + k + j]) + md[k + j];
    *(uint4*)(p.hbuf + i) = make_uint4(pack2(h[0], h[1]), pack2(h[2], h[3]), pack2(h[4], h[5]), pack2(h[6], h[7]));
  }
}

__device__ __forceinline__ void ret_proj_phase(const P& p, int layer, unsigned char* smem) {
  const bf16_t* W = p.retWinT + (long)layer * 6144 * 1024;
  const int ntn = 48, ntm = 64;
  for (int it = blockIdx.x; it < ntn * ntm; it += gridDim.x) {
    int tn = it % ntn, tm = it / ntn;
    f32x16 acc[2][4];
#pragma unroll
    for (int i = 0; i < 2; i++)
#pragma unroll
      for (int j = 0; j < 4; j++)
#pragma unroll
        for (int r = 0; r < 16; r++) acc[i][j][r] = 0.f;
    gemm_tile256(p.hbuf + (long)tm * 256 * 1024, 1024, W + (long)tn * 128 * 1024, 1024, 1024, acc, smem);
    const int m0 = tm * 256;
    const int b = m0 / S_, s0 = m0 % S_;
    if (tn < 16) {
      const bool isK = tn >= 8;
      const int hd = (tn & 7) >> 1, t2 = tn & 1;
      const float lg = log1pf(-exp2f(-5.0f - (float)hd));
      const long bh = b * 4 + hd;
      epi_pairs256(acc, [&](int row0, int col0, const float* v0, const float* v1) {
        int fi = t2 * 64 + col0;
        float o1[4], o2[4];
#pragma unroll
        for (int j = 0; j < 4; j++) {
          int s = s0 + row0 + j;
          float2 cs = *(const float2*)(p.cs + 2 * ((long)s * 128 + fi));
          float x1 = v0[j], x2 = v1[j];
          float r1 = x1 * cs.x - x2 * cs.y, r2 = x1 * cs.y + x2 * cs.x;
          int cpos = s & 127;
          float sc = isK ? 0.0625f * __expf(-(float)(cpos + 1) * lg) : __expf((float)(cpos + 1) * lg);
          o1[j] = r1 * sc;
          o2[j] = r2 * sc;
        }
        int p1 = fi, p2 = 128 + fi;
        bf16_t* dst = isK ? p.Kd : p.Qd;
#pragma unroll
        for (int j = 0; j < 4; j++) {
          long s = s0 + row0 + j;
          dst[(bh * S_ + s) * 256 + p1] = f2bf(o1[j]);
          dst[(bh * S_ + s) * 256 + p2] = f2bf(o2[j]);
        }
        if (isK) {
          long s = s0 + row0;
          *(uint2*)(p.KdT + ((bh * 64 + (s >> 7)) * 256 + p1) * 128 + (s & 127)) = make_uint2(pack2(o1[0], o1[1]), pack2(o1[2], o1[3]));
          *(uint2*)(p.KdT + ((bh * 64 + (s >> 7)) * 256 + p2) * 128 + (s & 127)) = make_uint2(pack2(o2[0], o2[1]), pack2(o2[2], o2[3]));
        }
      });
    } else if (tn < 32) {
      const int hd = (tn - 16) >> 2, e0 = ((tn - 16) & 3) * 128;
      const long bh = b * 4 + hd;
      epi_pairs256(acc, [&](int row0, int col0, const float* v0, const float* v1) {
        long s = s0 + row0;
        *(uint2*)(p.VT + ((bh * 64 + (s >> 7)) * 512 + e0 + col0) * 128 + (s & 127)) = make_uint2(pack2(v0[0], v0[1]), pack2(v0[2], v0[3]));
        *(uint2*)(p.VT + ((bh * 64 + (s >> 7)) * 512 + e0 + col0 + 64) * 128 + (s & 127)) = make_uint2(pack2(v1[0], v1[1]), pack2(v1[2], v1[3]));
      });
    } else {
      const int c0 = (tn - 32) * 128;
      epi_pairs256(acc, [&](int row0, int col0, const float* v0, const float* v1) {
#pragma unroll
        for (int j = 0; j < 4; j++) {
          long t = m0 + row0 + j;
          p.Gs[t * 2048 + c0 + col0] = f2bf(silu_f(v0[j]));
          p.Gs[t * 2048 + c0 + col0 + 64] = f2bf(silu_f(v1[j]));
        }
      });
    }
  }
}

__device__ __forceinline__ void ret_up_phase(const P& p, unsigned char* smem) {
  const int nU = 8 * 64 * 8;
  const int nP = 8 * 64;
  for (int it0 = blockIdx.x; it0 < nU + nP; it0 += gridDim.x) {
    const int it = item_swz(it0, nU + nP);
    f32x16 acc[2][2];
    zero_acc(acc);
    if (it < nU) {
      int sub = it & 7, n = (it >> 3) & 63, bh = it >> 9;
      int et = sub >> 1, dt = sub & 1;
      gemm_tile(p.VT + ((long)(bh * 64 + n) * 512 + et * 128) * 128, 128, p.KdT + ((long)(bh * 64 + n) * 256 + dt * 128) * 128, 128,
                128, acc, smem);
      bf16_t* dst = p.ST + ((long)(bh * 64 + n) * 512 + et * 128) * 256 + dt * 128;
      epi_pairs(acc, [&](int row0, int col0, const float* v0, const float* v1) {
#pragma unroll
        for (int j = 0; j < 4; j++) {
          dst[(long)(row0 + j) * 256 + col0] = f2bf(v0[j]);
          dst[(long)(row0 + j) * 256 + col0 + 64] = f2bf(v1[j]);
        }
      });
    } else {
      int i2 = it - nU;
      int n = i2 & 63, bh = i2 >> 6;
      gemm_tile(p.Qd + ((long)bh * S_ + n * 128) * 256, 256, p.Kd + ((long)bh * S_ + n * 128) * 256, 256, 256, acc, smem);
      bf16_t* dst = p.Pb + (long)(bh * 64 + n) * 128 * 128;
      epi_pairs(acc, [&](int row0, int col0, const float* v0, const float* v1) {
#pragma unroll
        for (int j = 0; j < 4; j++) {
          int r = row0 + j;
          dst[r * 128 + col0] = f2bf(r >= col0 ? v0[j] : 0.f);
          dst[r * 128 + col0 + 64] = f2bf(r >= col0 + 64 ? v1[j] : 0.f);
        }
      });
    }
  }
}

__device__ __forceinline__ void ret_scan_phase(const P& p) {
  const long per = 512L * 256;
  long total = 8L * per / 8;
  for (long i = (long)blockIdx.x * 256 + otid(); i < total; i += (long)gridDim.x * 256) {
    long e = i * 8;
    int bh = (int)(e / per);
    long off = e % per;
    int hd = bh & 3;
    float cdec = __expf(128.f * log1pf(-exp2f(-5.0f - (float)hd)));
    float st[8];
#pragma unroll
    for (int j = 0; j < 8; j++) st[j] = 0.f;
    bf16_t* base = p.ST + (long)bh * 64 * per + off;
    uint4 u = *(const uint4*)base;
    for (int n = 0; n < 64; n++) {
      uint4 un = u;
      if (n + 1 < 64) un = *(const uint4*)(base + (long)(n + 1) * per);
      *(uint4*)(base + (long)n * per) = make_uint4(pack2(st[0], st[1]), pack2(st[2], st[3]), pack2(st[4], st[5]), pack2(st[6], st[7]));
      unsigned w[4] = {u.x, u.y, u.z, u.w};
#pragma unroll
      for (int j = 0; j < 4; j++) {
        st[2 * j] = cdec * (st[2 * j] + __uint_as_float(w[j] << 16));
        st[2 * j + 1] = cdec * (st[2 * j + 1] + __uint_as_float(w[j] & 0xffff0000u));
      }
      u = un;
    }
  }
}

__device__ __forceinline__ void ret_out_phase(const P& p, unsigned char* smem) {
  const int nitems = 8 * 64 * 4;
  for (int it0 = blockIdx.x; it0 < nitems; it0 += gridDim.x) {
    const int it = item_swz(it0, nitems);
    int et = it & 3, n = (it >> 2) & 63, bh = it >> 8;
    int b = bh >> 2, hd = bh & 3;
    f32x16 acc[2][2];
    zero_acc(acc);
    gemm_tile(p.Pb + (long)(bh * 64 + n) * 128 * 128, 128, p.VT + ((long)(bh * 64 + n) * 512 + et * 128) * 128, 128, 128, acc, smem);
    gemm_tile(p.Qd + ((long)bh * S_ + n * 128) * 256, 256, p.ST + ((long)(bh * 64 + n) * 512 + et * 128) * 256, 256, 256, acc, smem);
    bf16_t* dst = p.Ob + ((long)b * S_ + n * 128) * 2048 + hd * 512 + et * 128;
    epi_pairs(acc, [&](int row0, int col0, const float* v0, const float* v1) {
#pragma unroll
      for (int j = 0; j < 4; j++) {
        dst[(long)(row0 + j) * 2048 + col0] = f2bf(v0[j]);
        dst[(long)(row0 + j) * 2048 + col0 + 64] = f2bf(v1[j]);
      }
    });
  }
}

__device__ __forceinline__ void ret_gn_phase(const P& p) {
  const int tid_ = otid(); const int lane = tid_ & 63, wave = tid_ >> 6;
  for (int t = blockIdx.x * 4 + wave; t < T_; t += gridDim.x * 4) {
#pragma unroll
    for (int hd = 0; hd < 4; hd++) {
      long off = (long)t * 2048 + hd * 512 + lane * 8;
      uint4 o = *(const uint4*)(p.Ob + off);
      uint4 g = *(const uint4*)(p.Gs + off);
      unsigned ow[4] = {o.x, o.y, o.z, o.w}, gw[4] = {g.x, g.y, g.z, g.w};
      float ov[8], gv[8];
#pragma unroll
      for (int j = 0; j < 4; j++) {
        ov[2 * j] = __uint_as_float(ow[j] << 16);
        ov[2 * j + 1] = __uint_as_float(ow[j] & 0xffff0000u);
        gv[2 * j] = __uint_as_float(gw[j] << 16);
        gv[2 * j + 1] = __uint_as_float(gw[j] & 0xffff0000u);
      }
      float s = 0.f;
#pragma unroll
      for (int j = 0; j < 8; j++) s += ov[j];
      float mu = wave_allsum(s) * (1.f / 512.f);
      float q = 0.f;
#pragma unroll
      for (int j = 0; j < 8; j++) q += (ov[j] - mu) * (ov[j] - mu);
      float rstd = rsqrtf(wave_allsum(q) * (1.f / 512.f) + LN_EPS_);
      float r[8];
#pragma unroll
      for (int j = 0; j < 8; j++) r[j] = gv[j] * (ov[j] - mu) * rstd;
      *(uint4*)(p.Gs + off) = make_uint4(pack2(r[0], r[1]), pack2(r[2], r[3]), pack2(r[4], r[5]), pack2(r[6], r[7]));
    }
  }
}

__device__ __forceinline__ void wo_phase(const P& p, int layer, const bf16_t* A, const bf16_t* WoT, int K, unsigned char* smem) {
  const float* xres = layer == 0 ? p.x : p.xbuf;
  const int ntn = 8, ntm = 64;
#pragma unroll 1
  for (int it = blockIdx.x; it < ntn * ntm; it += gridDim.x) {
    int tn, tm;
    tile_map(it, ntm, ntn, 1, tm, tn);
    f32x16 acc[2][4];
#pragma unroll
    for (int i = 0; i < 2; i++)
#pragma unroll
      for (int j = 0; j < 4; j++)
#pragma unroll
        for (int r = 0; r < 16; r++) acc[i][j][r] = 0.f;
    gemm_tile256(A + (long)tm * 256 * K, K, WoT + (long)tn * 128 * K, K, K, acc, smem);
    const int m0 = tm * 256, n0 = tn * 128;
    const int b = m0 / S_;
    const float* g1 = p.mods + (layer * 2 + b) * 6144 + 2048;
    epi_pairs256(acc, [&](int row0, int col0, const float* v0, const float* v1) {
      int c = n0 + col0;
      float ga = g1[c], gb = g1[c + 64];
#pragma unroll
      for (int j = 0; j < 4; j++) {
        long o = (long)(m0 + row0 + j) * 1024 + c;
        p.xbuf[o] = ALPHA_ * xres[o] + ga * v0[j];
        p.xbuf[o + 64] = ALPHA_ * xres[o + 64] + gb * v1[j];
      }
    });
  }
}

__device__ __forceinline__ void ln1_phase(const P& p, int layer) {
  const int tid_ = otid(); const int lane = tid_ & 63, wave = tid_ >> 6;
  const float* lg = p.ln_g + (layer * 2 + 0) * 1024;
  const float* lb = p.ln_b + (layer * 2 + 0) * 1024;
  for (int t = blockIdx.x * 4 + wave; t < T_; t += gridDim.x * 4) {
    int b = t / S_;
    const float* md = p.mods + (layer * 2 + b) * 6144;
    float* xr = p.xbuf + (long)t * 1024;
    float z[16];
#pragma unroll
    for (int j = 0; j < 2; j++) {
      float4 a = *(const float4*)(xr + j * 512 + lane * 8), bq = *(const float4*)(xr + j * 512 + lane * 8 + 4);
      z[j * 8 + 0] = a.x; z[j * 8 + 1] = a.y; z[j * 8 + 2] = a.z; z[j * 8 + 3] = a.w;
      z[j * 8 + 4] = bq.x; z[j * 8 + 5] = bq.y; z[j * 8 + 6] = bq.z; z[j * 8 + 7] = bq.w;
    }
    float s = 0.f;
#pragma unroll
    for (int j = 0; j < 16; j++) s += z[j];
    float mu = wave_allsum(s) * (1.f / 1024.f);
    float q = 0.f;
#pragma unroll
    for (int j = 0; j < 16; j++) q += (z[j] - mu) * (z[j] - mu);
    float rstd = rsqrtf(wave_allsum(q) * (1.f / 1024.f) + LN_EPS_);
#pragma unroll
    for (int j = 0; j < 2; j++) {
      int k0 = j * 512 + lane * 8;
      float xo[8], h[8];
#pragma unroll
      for (int i = 0; i < 8; i++) {
        xo[i] = (z[j * 8 + i] - mu) * rstd * lg[k0 + i] + lb[k0 + i];
        h[i] = xo[i] * (1.f + md[4 * 1024 + k0 + i]) + md[3 * 1024 + k0 + i];
      }
      *(float4*)(xr + k0) = make_float4(xo[0], xo[1], xo[2], xo[3]);
      *(float4*)(xr + k0 + 4) = make_float4(xo[4], xo[5], xo[6], xo[7]);
      *(uint4*)(p.hbuf + (long)t * 1024 + k0) = make_uint4(pack2(h[0], h[1]), pack2(h[2], h[3]), pack2(h[4], h[5]), pack2(h[6], h[7]));
    }
  }
}

#define KSTR 132
__device__ __forceinline__ void peer_qscore_phase(const P& p, int layer, unsigned char* smem) {
  const bf16_t* W = p.wqT + (long)layer * 2048 * 1024;
  const bf16_t* keys = p.keysB + (long)layer * 16 * 128 * 128;
  bf16_t* sKeys = (bf16_t*)smem;
#pragma unroll 1
  for (int it = blockIdx.x; it < 16 * 128; it += gridDim.x) {
    int hc, tm;
    tile_map(it, 128, 16, 2, tm, hc);
    f32x16 acc[4];
#pragma unroll
    for (int i = 0; i < 4; i++)
#pragma unroll
      for (int r = 0; r < 16; r++) acc[i][r] = 0.f;
    const int tid = otid(), lane = tid & 63, wave = tid >> 6, hf = lane >> 5;
    uint4 kq_0, kq_1, kq_2, kq_3, kq_4, kq_5, kq_6, kq_7;
    {
      const bf16_t* kg = keys + (long)hc * 128 * 128 + (tid >> 4) * 128 + (tid & 15) * 8;
      kq_0 = *(const uint4*)(kg);
      kq_1 = *(const uint4*)(kg + 16 * 128);
      kq_2 = *(const uint4*)(kg + 32 * 128);
      kq_3 = *(const uint4*)(kg + 48 * 128);
      kq_4 = *(const uint4*)(kg + 64 * 128);
      kq_5 = *(const uint4*)(kg + 80 * 128);
      kq_6 = *(const uint4*)(kg + 96 * 128);
      kq_7 = *(const uint4*)(kg + 112 * 128);
    }
    gemm_tile_w41(W + (long)hc * 128 * 1024, 1024, p.hbuf + (long)tm * 128 * 1024, 1024, 1024, acc, smem);
    {
      bf16_t* kd = sKeys + (tid >> 4) * KSTR + (tid & 15) * 8;
#define KQ_ST(i, v)                                                   \
  *(uint2*)(kd + (i) * 16 * KSTR) = make_uint2(v.x, v.y);             \
  *(uint2*)(kd + (i) * 16 * KSTR + 4) = make_uint2(v.z, v.w);
      KQ_ST(0, kq_0) KQ_ST(1, kq_1) KQ_ST(2, kq_2) KQ_ST(3, kq_3) KQ_ST(4, kq_4) KQ_ST(5, kq_5) KQ_ST(6, kq_6) KQ_ST(7, kq_7)
#undef KQ_ST
    }
    bf16x8 qb[8];
#pragma unroll
    for (int i2 = 0; i2 < 8; i2++) {
      const int mi = i2 >> 1, u = i2 & 1;
      union { unsigned w[4]; bf16x8 v; } pf;
#pragma unroll
      for (int j = 0; j < 4; j++) pf.w[j] = pack2(acc[mi][8 * u + 2 * j], acc[mi][8 * u + 2 * j + 1]);
      qb[i2] = pf.v;
    }
    __syncthreads();
    f32x16 sc[4];
#pragma unroll
    for (int kt = 0; kt < 4; kt++) {
#pragma unroll
      for (int r = 0; r < 16; r++) sc[kt][r] = 0.f;
#pragma unroll
      for (int i2 = 0; i2 < 8; i2++) {
        const bf16_t* kp = sKeys + (kt * 32 + (lane & 31)) * KSTR + i2 * 16 + hf * 4;
        uint2 lo = *(const uint2*)kp, hi = *(const uint2*)(kp + 8);
        union { unsigned w[4]; bf16x8 v; } kf;
        kf.w[0] = lo.x; kf.w[1] = lo.y; kf.w[2] = hi.x; kf.w[3] = hi.y;
        sc[kt] = mfma32(kf.v, qb[i2], sc[kt]);
      }
    }
    float top[16];
#pragma unroll
    for (int i = 0; i < 16; i++) top[i] = -3.0e38f;
    const int jb = 127 - hf * 4;
#pragma unroll
    for (int kt = 0; kt < 4; kt++)
#pragma unroll
      for (int r = 0; r < 16; r++) {
        const int jc = kt * 32 + (r >> 2) * 8 + (r & 3);
        float x = __int_as_float((__float_as_int(sc[kt][r]) & ~127) | (jb - jc));
#pragma unroll
        for (int i = 15; i >= 1; i--) top[i] = __builtin_amdgcn_fmed3f(top[i - 1], top[i], x);
        top[0] = fmaxf(top[0], x);
      }
    float oth[16];
#pragma unroll
    for (int i = 0; i < 16; i++) oth[i] = __shfl_xor(top[i], 32);
#pragma unroll
    for (int k = 0; k < 16; k++) {
      float x = oth[k];
#pragma unroll
      for (int i = 15; i >= 1; i--) top[i] = __builtin_amdgcn_fmed3f(top[i - 1], top[i], x);
      top[0] = fmaxf(top[0], x);
    }
    if (hf == 0) {
      const int token = tm * 128 + wave * 32 + lane;
      float4* d = (float4*)(p.topk + ((long)token * 16 + hc) * 16);
      d[0] = make_float4(top[0], top[1], top[2], top[3]);
      d[1] = make_float4(top[4], top[5], top[6], top[7]);
      d[2] = make_float4(top[8], top[9], top[10], top[11]);
      d[3] = make_float4(top[12], top[13], top[14], top[15]);
    }
  }
}

__device__ __forceinline__ void expert_dot(const int4& uq, const f32x2 (&h2)[8], float& d) {
  f32x2 acc = {0.f, 0.f};
  const int uw[4] = {uq.x, uq.y, uq.z, uq.w};
#pragma unroll
  for (int q = 0; q < 4; q++) {
    acc = __builtin_elementwise_fma(__builtin_amdgcn_cvt_pk_f32_fp8(uw[q], false), h2[2 * q], acc);
    acc = __builtin_elementwise_fma(__builtin_amdgcn_cvt_pk_f32_fp8(uw[q], true), h2[2 * q + 1], acc);
  }
  d = acc.x + acc.y;
}
__device__ __forceinline__ void expert_axpy(const int4& vq, float a, f32x2 (&y2)[8]) {
  const int vw[4] = {vq.x, vq.y, vq.z, vq.w};
  const f32x2 a2 = {a, a};
#pragma unroll
  for (int q = 0; q < 4; q++) {
    y2[2 * q] = __builtin_elementwise_fma(__builtin_amdgcn_cvt_pk_f32_fp8(vw[q], false), a2, y2[2 * q]);
    y2[2 * q + 1] = __builtin_elementwise_fma(__builtin_amdgcn_cvt_pk_f32_fp8(vw[q], true), a2, y2[2 * q + 1]);
  }
}
#define EXG 4
__device__ __forceinline__ void peer_expert_phase(const P& p, int layer, unsigned char* smem, const bool dry) {
  const int tid_ = otid();
  const int lane = tid_ & 63, wave = tid_ >> 6;
  int4* elist = (int4*)smem + wave * 128;
  int* tkl = (int*)(smem + 8192) + wave * 256;
  int ci = 0, cj = 0, cnt = 0;
  bool isc = false;
  for (int i = 0; i < 16; i++)
    for (int j = 0; j < 16; j++)
      if ((i + 1) * (j + 1) <= 16) {
        if (cnt == lane) { ci = i; cj = j; isc = true; }
        cnt++;
      }
  const unsigned char* U = p.uB + (long)layer * 16384 * 2048;
  const unsigned char* V = U + 1024;
  const float* SU = p.su + layer * 16384;
  const float* SV = p.sv + layer * 16384;
  const float* lg = p.ln_g + (layer * 2 + 1) * 1024;
  const float* lb = p.ln_b + (layer * 2 + 1) * 1024;
  __syncthreads();
#pragma unroll 1
  for (int t = blockIdx.x * 4 + wave; t < T_; t += gridDim.x * 4) {
    int b = t / S_;
    const float* md = p.mods + (layer * 2 + b) * 6144;
    float* xr = p.xbuf + (long)t * 1024;
    float xv[16];
    f32x2 h2[8];
#pragma unroll
    for (int j = 0; j < 2; j++) {
      float4 a = *(const float4*)(xr + j * 512 + lane * 8), bq = *(const float4*)(xr + j * 512 + lane * 8 + 4);
      xv[j * 8 + 0] = a.x; xv[j * 8 + 1] = a.y; xv[j * 8 + 2] = a.z; xv[j * 8 + 3] = a.w;
      xv[j * 8 + 4] = bq.x; xv[j * 8 + 5] = bq.y; xv[j * 8 + 6] = bq.z; xv[j * 8 + 7] = bq.w;
    }
#pragma unroll
    for (int j = 0; j < 2; j++)
#pragma unroll
      for (int i = 0; i < 8; i += 2) {
        int k = j * 512 + lane * 8 + i;
        f32x2 hh;
        hh.x = xv[j * 8 + i] * (1.f + md[4 * 1024 + k]) + md[3 * 1024 + k];
        hh.y = xv[j * 8 + i + 1] * (1.f + md[4 * 1024 + k + 1]) + md[3 * 1024 + k + 1];
        h2[(j * 8 + i) >> 1] = hh;
      }
    ((int4*)tkl)[lane] = ((const int4*)(p.topk + (long)t * 256))[lane];
    __builtin_amdgcn_wave_barrier();
#pragma unroll 1
    for (int head = 0; head < 8; head++) {
      int key = 0;
      if (lane < 32) key = tkl[head * 32 + lane];
      int k0 = __shfl(key, ci), k1 = __shfl(key, 16 + cj);
      float s = isc ? (__int_as_float(k0 & ~127) + __int_as_float(k1 & ~127)) : -3.0e38f;
      int rank = 0;
#pragma unroll
      for (int c2 = 0; c2 < 50; c2++) {
        float s2 = __int_as_float(__builtin_amdgcn_readlane(__float_as_int(s), c2));
        rank += (s2 > s || (s2 == s && c2 < lane)) ? 1 : 0;
      }
      bool sel = isc && rank < 16;
      unsigned long long b0 = __ballot(isc && rank == 0);
      int l0 = __ffsll((long long)b0) - 1;
      float mx = __shfl(s, l0);
      float w = sel ? __expf(s - mx) : 0.f;
      float tot = wave_allsum_fast(w);
      w = w / tot;
      if (sel) {
        int e = (127 - (k0 & 127)) * 128 + (127 - (k1 & 127));
        elist[head * 16 + rank] = make_int4(e, __float_as_int(w), 0, 0);
      }
    }
    __builtin_amdgcn_wave_barrier();
    f32x2 y2[8];
#pragma unroll
    for (int i = 0; i < 8; i++) y2[i] = (f32x2){0.f, 0.f};
    int4 ua[EXG], va[EXG], ub[EXG], vb[EXG];
#pragma unroll
    for (int i = 0; i < EXG; i++) {
      int e = elist[i].x;
      ua[i] = *((const int4*)(U + (long)e * 2048) + lane);
      va[i] = *((const int4*)(V + (long)e * 2048) + lane);
    }
    {
      int e0 = elist[lane].x, e1 = elist[lane + 64].x;
      float su0 = SU[e0], sv0 = SV[e0], su1 = SU[e1], sv1 = SV[e1];
      elist[lane].z = __float_as_int(su0);
      elist[lane].w = __float_as_int(sv0);
      elist[lane + 64].z = __float_as_int(su1);
      elist[lane + 64].w = __float_as_int(sv1);
    }
    __builtin_amdgcn_wave_barrier();
#pragma unroll 1
    for (int g = 0; g < 128 / EXG; g += 2) {
#pragma unroll
      for (int i = 0; i < EXG; i++) {
        int e = elist[(g + 1) * EXG + i].x;
        ub[i] = *((const int4*)(U + (long)e * 2048) + lane);
        vb[i] = *((const int4*)(V + (long)e * 2048) + lane);
      }
#pragma unroll
      for (int i = 0; i < EXG; i++) {
        int4 ew = elist[g * EXG + i];
        float d;
        expert_dot(ua[i], h2, d);
        d = wave_allsum_fast(d) * __int_as_float(ew.z);
        float a = gelu_t(d) * __int_as_float(ew.y) * __int_as_float(ew.w);
        expert_axpy(va[i], a, y2);
      }
      if (g + 2 < 128 / EXG) {
#pragma unroll
        for (int i = 0; i < EXG; i++) {
          int e = elist[(g + 2) * EXG + i].x;
          ua[i] = *((const int4*)(U + (long)e * 2048) + lane);
          va[i] = *((const int4*)(V + (long)e * 2048) + lane);
        }
      }
#pragma unroll
      for (int i = 0; i < EXG; i++) {
        int4 ew = elist[(g + 1) * EXG + i];
        float d;
        expert_dot(ub[i], h2, d);
        d = wave_allsum_fast(d) * __int_as_float(ew.z);
        float a = gelu_t(d) * __int_as_float(ew.y) * __int_as_float(ew.w);
        expert_axpy(vb[i], a, y2);
      }
    }
    __builtin_amdgcn_wave_barrier();
    float z[16];
    float s = 0.f;
#pragma unroll
    for (int j = 0; j < 2; j++)
#pragma unroll
      for (int i = 0; i < 8; i++) {
        int k = j * 512 + lane * 8 + i;
        float yv = (i & 1) ? y2[(j * 8 + i) >> 1].y : y2[(j * 8 + i) >> 1].x;
        z[j * 8 + i] = ALPHA_ * xv[j * 8 + i] + md[5 * 1024 + k] * yv;
        s += z[j * 8 + i];
      }
    float mu = wave_allsum_fast(s) * (1.f / 1024.f);
    float q = 0.f;
#pragma unroll
    for (int j = 0; j < 16; j++) q += (z[j] - mu) * (z[j] - mu);
    float rstd = rsqrtf(wave_allsum_fast(q) * (1.f / 1024.f) + LN_EPS_);
    float* dstx = dry ? ((float*)p.qp + (long)t * 1024) : ((layer == 3) ? (p.out + (long)t * 1024) : xr);
    const float* mdn = p.mods + (((layer + 1) & 3) * 2 + b) * 6144;
    const float* kvm = p.kvmod + b * 2048;
#pragma unroll
    for (int j = 0; j < 2; j++) {
      int k0 = j * 512 + lane * 8;
      float xo[8], h[8], xs[8];
#pragma unroll
      for (int i = 0; i < 8; i++) {
        xo[i] = (z[j * 8 + i] - mu) * rstd * lg[k0 + i] + lb[k0 + i];
        h[i] = xo[i] * (1.f + mdn[1024 + k0 + i]) + mdn[k0 + i];
        xs[i] = xo[i] * (1.f + kvm[1024 + k0 + i]) + kvm[k0 + i];
      }
      *(float4*)(dstx + k0) = make_float4(xo[0], xo[1], xo[2], xo[3]);
      *(float4*)(dstx + k0 + 4) = make_float4(xo[4], xo[5], xo[6], xo[7]);
      if (layer < 3 && !dry)
        *(uint4*)(p.hbuf + (long)t * 1024 + k0) = make_uint4(pack2(h[0], h[1]), pack2(h[2], h[3]), pack2(h[4], h[5]), pack2(h[6], h[7]));
      if (layer == 1 && !dry)
        *(uint4*)(p.xsbuf + (long)t * 1024 + k0) = make_uint4(pack2(xs[0], xs[1]), pack2(xs[2], xs[3]), pack2(xs[4], xs[5]), pack2(xs[6], xs[7]));
    }
  }
}

__device__ __forceinline__ void kv_proj_phase(const P& p, unsigned char* smem) {
  const int ntn = 12, ntm = 128;
  const long partsz = 8L * S_ * 64;
  for (int it = blockIdx.x; it < ntn * ntm; it += gridDim.x) {
    int tn, tm;
    tile_map(it, ntm, ntn, 1, tm, tn);
    f32x16 acc[2][2];
    zero_acc(acc);
    gemm_tile(p.xsbuf + (long)tm * 128 * 1024, 1024, p.kvWT + (long)tn * 128 * 1024, 1024, 1024, acc, smem);
    const int m0 = tm * 128, b = m0 / S_, s0 = m0 % S_;
    const int part = tn >> 1, ga = (tn & 1) * 2;
    bf16_t* base = p.kvbuf + part * partsz;
    const bool tr = (part == 3 || part == 5);
    epi_pairs(acc, [&](int row0, int col0, const float* v0, const float* v1) {
      long bg0 = b * 4 + ga, bg1 = bg0 + 1;
      int d = col0;
      long s = s0 + row0;
      if (tr) {
        *(uint2*)(base + ((bg0 * 64 + (s >> 7)) * 64 + d) * 128 + (s & 127)) = make_uint2(pack2(v0[0], v0[1]), pack2(v0[2], v0[3]));
        *(uint2*)(base + ((bg1 * 64 + (s >> 7)) * 64 + d) * 128 + (s & 127)) = make_uint2(pack2(v1[0], v1[1]), pack2(v1[2], v1[3]));
      } else {
#pragma unroll
        for (int j = 0; j < 4; j++) {
          base[(bg0 * S_ + s + j) * 64 + d] = f2bf(v0[j]);
          base[(bg1 * S_ + s + j) * 64 + d] = f2bf(v1[j]);
        }
      }
    });
  }
}

__device__ __forceinline__ void cmp1_phase(const P& p, unsigned char* smem) {
  const long partsz = 8L * S_ * 64;
  for (int it = blockIdx.x; it < 2 * 8 * 4 * 2; it += gridDim.x) {
    int tn = it & 1, tm = (it >> 1) & 3, bg = (it >> 3) & 7, c = it >> 6;
    f32x16 acc[2][2];
    zero_acc(acc);
    gemm_tile(p.kvbuf + c * partsz + (long)bg * S_ * 64 + (long)tm * 128 * 1024, 1024, p.w1T + ((long)c * 256 + tn * 128) * 2048, 2048,
              2048, acc, smem);
    bf16_t* dst = p.hid + ((long)(c * 8 + bg) * 512 + tm * 128) * 256 + tn * 128;
    const float* bp = p.biasp + c * 256 + tn * 128;
    epi_pairs(acc, [&](int row0, int col0, const float* v0, const float* v1) {
      float ba = bp[col0], bb = bp[col0 + 64];
#pragma unroll
      for (int j = 0; j < 4; j++) {
        dst[(long)(row0 + j) * 256 + col0] = f2bf(gelu_t(v0[j] + ba));
        dst[(long)(row0 + j) * 256 + col0 + 64] = f2bf(gelu_t(v1[j] + bb));
      }
    });
  }
}

__device__ __forceinline__ void cmp2_phase(const P& p, unsigned char* smem) {
  for (int it = blockIdx.x; it < 2 * 8 * 4; it += gridDim.x) {
    int tm = it & 3, bg = (it >> 2) & 7, c = it >> 5;
    f32x16 acc[2][2];
    zero_acc(acc);
    gemm_tile(p.hid + ((long)(c * 8 + bg) * 512 + tm * 128) * 256, 256, p.w2T + (long)c * 128 * 256, 256, 256, acc, smem);
    epi_pairs(acc, [&](int row0, int col0, const float* v0, const float* v1) {
      int n = tm * 128 + row0;
      if (c == 0) {
#pragma unroll
        for (int j = 0; j < 4; j++) p.Kc[((long)bg * 512 + n + j) * 64 + col0] = f2bf(v0[j]);
      } else {
        *(uint2*)(p.VcT + ((long)bg * 64 + col0) * 512 + n) = make_uint2(pack2(v0[0], v0[1]), pack2(v0[2], v0[3]));
      }
    });
  }
}

__device__ __forceinline__ void nsa_q_phase(const P& p, int lb, unsigned char* smem) {
  const bf16_t* W = p.nsaWinT + (long)lb * 1152 * 1024;
  const int ntn = 9, ntm = 128;
  for (int it = blockIdx.x; it < ntn * ntm; it += gridDim.x) {
    int tn, tm;
    tile_map(it, ntm, ntn, 1, tm, tn);
    f32x16 acc[2][2];
    zero_acc(acc);
    gemm_tile(p.hbuf + (long)tm * 128 * 1024, 1024, W + (long)tn * 128 * 1024, 1024, 1024, acc, smem);
    const int m0 = tm * 128, n0 = tn * 128;
    epi_pairs(acc, [&](int row0, int col0, const float* v0, const float* v1) {
#pragma unroll
      for (int j = 0; j < 4; j++) {
        long t = m0 + row0 + j;
        int ca = n0 + col0, cb = ca + 64;
        if (ca < 1024) p.Qn[t * 1024 + ca] = f2bf(v0[j] * 0.18033688011112042f);
        else if (ca < 1072) p.gate[t * 48 + ca - 1024] = sigmoid_f(v0[j]);
        if (cb < 1024) p.Qn[t * 1024 + cb] = f2bf(v1[j] * 0.18033688011112042f);
        else if (cb < 1072) p.gate[t * 48 + cb - 1024] = sigmoid_f(v1[j]);
      }
    });
  }
}

#define VSTR 132
__device__ __forceinline__ void stage_K(const bf16_t* __restrict__ src, bf16_t* sK) {
  const int tid = otid();
#pragma unroll
  for (int i = 0; i < 4; i++) {
    int ch = tid + i * 256;
    int r = ch >> 3, c = (ch & 7) * 8;
    *(uint4*)(sK + r * LSTR + c) = *(const uint4*)(src + r * 64 + c);
  }
}
__device__ __forceinline__ void stage_VT(const bf16_t* __restrict__ src, long ld, bf16_t* sV) {
  const int tid = otid();
#pragma unroll
  for (int i = 0; i < 4; i++) {
    int ch = tid + i * 256;
    int r = ch >> 4, c = (ch & 15) * 8;
    uint4 v = *(const uint4*)(src + (long)r * ld + c);
    *(uint2*)(sV + r * VSTR + c) = make_uint2(v.x, v.y);
    *(uint2*)(sV + r * VSTR + c + 4) = make_uint2(v.z, v.w);
  }
}
__device__ __forceinline__ void attn_qk(const bf16_t* sK, const bf16x8 (&qf)[4], f32x16 (&st)[2], int lane) {
#pragma unroll
  for (int mi = 0; mi < 2; mi++) {
#pragma unroll
    for (int r = 0; r < 16; r++) st[mi][r] = 0.f;
#pragma unroll
    for (int kk = 0; kk < 4; kk++) {
      bf16x8 kf = *(const bf16x8*)(sK + (mi * 32 + (lane & 31)) * LSTR + kk * 16 + (lane >> 5) * 8);
      st[mi] = mfma32(kf, qf[kk], st[mi]);
    }
  }
}
__device__ __forceinline__ void attn_pv(const bf16_t* sV, const f32x16 (&pt)[2], f32x16 (&o)[2], int lane) {
#pragma unroll
  for (int i2 = 0; i2 < 4; i2++) {
    const int mi = i2 >> 1, u = i2 & 1;
    union { unsigned w[4]; bf16x8 v; } pf;
#pragma unroll
    for (int j = 0; j < 4; j++) pf.w[j] = pack2(pt[mi][8 * u + 2 * j], pt[mi][8 * u + 2 * j + 1]);
#pragma unroll
    for (int di = 0; di < 2; di++) {
      const bf16_t* vp = sV + (di * 32 + (lane & 31)) * VSTR + i2 * 16 + (lane >> 5) * 4;
      uint2 lo = *(const uint2*)vp, hi = *(const uint2*)(vp + 8);
      union { unsigned w[4]; bf16x8 v; } vf;
      vf.w[0] = lo.x; vf.w[1] = lo.y; vf.w[2] = hi.x; vf.w[3] = hi.y;
      o[di] = mfma32(vf.v, pf.v, o[di]);
    }
  }
}
__device__ __forceinline__ void add_out(unsigned (&outp)[2][8], const f32x16 (&o)[2], float sc) {
#pragma unroll
  for (int di = 0; di < 2; di++)
#pragma unroll
    for (int j = 0; j < 8; j++) {
      float a = __uint_as_float(outp[di][j] << 16) + sc * o[di][2 * j];
      float b = __uint_as_float(outp[di][j] & 0xffff0000u) + sc * o[di][2 * j + 1];
      outp[di][j] = pack2(a, b);
    }
}
__device__ __forceinline__ void flash_branch(const int MODE, const bf16_t* __restrict__ Kg, const bf16_t* __restrict__ VTg, int kt_lo, int kt_hi,
                                             const bf16x8 (&qf)[4], int t, int q0, const unsigned* sSelq,
                                             float gate, unsigned (&outp)[2][8], bf16_t* sK, bf16_t* sV, int lane) {
  float m = -1e30f, l = 0.f;
  f32x16 o[2];
#pragma unroll
  for (int di = 0; di < 2; di++)
#pragma unroll
    for (int r = 0; r < 16; r++) o[di][r] = 0.f;
  const int tid = otid();
  lane = tid & 63;
  const int hf = lane >> 5;
  const int wlo = (MODE == 2) ? (q0 + 31 - 512) : -1;
  uint4 k_0, k_1, k_2, k_3, v_0, v_1, v_2, v_3;
  const bf16_t* kp = Kg + (long)(tid >> 3) * 64 + (tid & 7) * 8;
  const bf16_t* vp = VTg + (long)(tid >> 4) * 128 + (tid & 15) * 8;
  bf16_t* skw = sK + (tid >> 3) * LSTR + (tid & 7) * 8;
  bf16_t* svw = sV + (tid >> 4) * VSTR + (tid & 15) * 8;
#define FB_LOAD(KT)                                                    \
  k_0 = *(const uint4*)(kp + (long)(KT) * 8192);                       \
  k_1 = *(const uint4*)(kp + (long)(KT) * 8192 + 32 * 64);             \
  k_2 = *(const uint4*)(kp + (long)(KT) * 8192 + 64 * 64);             \
  k_3 = *(const uint4*)(kp + (long)(KT) * 8192 + 96 * 64);             \
  v_0 = *(const uint4*)(vp + (long)(KT) * 8192);                       \
  v_1 = *(const uint4*)(vp + (long)(KT) * 8192 + 16 * 128);            \
  v_2 = *(const uint4*)(vp + (long)(KT) * 8192 + 32 * 128);            \
  v_3 = *(const uint4*)(vp + (long)(KT) * 8192 + 48 * 128);
#define FB_STORE()                                                     \
  *(uint4*)(skw) = k_0;                                                \
  *(uint4*)(skw + 32 * LSTR) = k_1;                                    \
  *(uint4*)(skw + 64 * LSTR) = k_2;                                    \
  *(uint4*)(skw + 96 * LSTR) = k_3;                                    \
  *(uint2*)(svw) = make_uint2(v_0.x, v_0.y);                           \
  *(uint2*)(svw + 4) = make_uint2(v_0.z, v_0.w);                       \
  *(uint2*)(svw + 16 * VSTR) = make_uint2(v_1.x, v_1.y);               \
  *(uint2*)(svw + 16 * VSTR + 4) = make_uint2(v_1.z, v_1.w);           \
  *(uint2*)(svw + 32 * VSTR) = make_uint2(v_2.x, v_2.y);               \
  *(uint2*)(svw + 32 * VSTR + 4) = make_uint2(v_2.z, v_2.w);           \
  *(uint2*)(svw + 48 * VSTR) = make_uint2(v_3.x, v_3.y);               \
  *(uint2*)(svw + 48 * VSTR + 4) = make_uint2(v_3.z, v_3.w);
  FB_LOAD(kt_lo);
#pragma unroll 1
  for (int kt = kt_lo; kt <= kt_hi; kt++) {
    unsigned two = 3u;
    if (MODE == 1) {
      unsigned wsel = sSelq[kt >> 4];
      two = (wsel >> ((2 * kt) & 31)) & 3u;
    }
    __syncthreads();
    FB_STORE();
    __syncthreads();
    if (kt < kt_hi) { FB_LOAD(kt + 1); }
#pragma unroll
    for (int half = 0; half < 2; half++) {
      f32x16 st[2];
      attn_qk(sK + half * 64 * LSTR, qf, st, lane);
      const bool bsel = (two >> half) & 1u;
      const int kbase = kt * 128 + half * 64;
      const bool interior = (kbase + 63 <= q0) && (kbase > wlo);
      float mnew, corr;
      if (interior) {
        float mx = st[0][0];
#pragma unroll
        for (int mi = 0; mi < 2; mi++)
#pragma unroll
          for (int r = 0; r < 16; r++) mx = fmaxf(mx, st[mi][r]);
        mx = bsel ? mx : -1e30f;
        mx = fmaxf(mx, __shfl_xor(mx, 32));
        mnew = fmaxf(m, mx);
        corr = ex2(m - mnew);
        const float c = bsel ? -mnew : -1e30f;
        const f32x2 c2 = {c, c};
        f32x2 ls2 = {0.f, 0.f};
#pragma unroll
        for (int mi = 0; mi < 2; mi++)
#pragma unroll
          for (int r = 0; r < 16; r += 2) {
            f32x2 v = {st[mi][r], st[mi][r + 1]};
            v = v + c2;
            v.x = ex2(v.x);
            v.y = ex2(v.y);
            st[mi][r] = v.x;
            st[mi][r + 1] = v.y;
            ls2 = ls2 + v;
          }
        l = l * corr + (ls2.x + ls2.y);
      } else {
        float mx = -1e30f;
        const int rel = bsel ? (t - (kbase + hf * 4)) : -1;
        const int rel2 = (MODE == 2) ? rel - 511 : -1000000;
#pragma unroll
        for (int mi = 0; mi < 2; mi++)
#pragma unroll
          for (int r = 0; r < 16; r++) {
            const int cr = mi * 32 + (r >> 2) * 8 + (r & 3);
            const bool valid = (cr <= rel) && (cr >= rel2);
            float sv = valid ? st[mi][r] : -1e30f;
            st[mi][r] = sv;
            mx = fmaxf(mx, sv);
          }
        mx = fmaxf(mx, __shfl_xor(mx, 32));
        mnew = fmaxf(m, mx);
        corr = ex2(m - mnew);
        float ls = 0.f;
#pragma unroll
        for (int mi = 0; mi < 2; mi++)
#pragma unroll
          for (int r = 0; r < 16; r++) {
            float sv = st[mi][r];
            float pv = (sv > -1e29f) ? ex2(sv - mnew) : 0.f;
            st[mi][r] = pv;
            ls += pv;
          }
        l = l * corr + ls;
      }
      m = mnew;
      if (__any(corr < 1.0f)) {
#pragma unroll
        for (int di = 0; di < 2; di++)
#pragma unroll
          for (int r = 0; r < 16; r++) o[di][r] *= corr;
      }
      attn_pv(sV + half * 64, st, o, lane);
    }
  }
#undef FB_LOAD
#undef FB_STORE
  float lt = l + __shfl_xor(l, 32);
  float sc = lt > 0.f ? gate / lt : 0.f;
  add_out(outp, o, sc);
}

__device__ __forceinline__ void nsa_attn_phase(const P& p, unsigned char* smem) {
  bf16_t* sK = (bf16_t*)smem;
  bf16_t* sV = (bf16_t*)(smem + 18432);
  unsigned* sImp = (unsigned*)(smem + 35328);
  unsigned* sSel = (unsigned*)(smem + 51840);
  unsigned* sAny = (unsigned*)(smem + 52352);
  const long partsz = 8L * S_ * 64;
  const int tid = otid(), lane = tid & 63, wave = tid >> 6;
  const int qi = lane & 31, hf = lane >> 5;
#pragma unroll 1
  for (int it0 = blockIdx.x; it0 < 2048; it0 += gridDim.x) {
    const int it = item_swz(it0, 2048);
    int bg = it >> 8, qtr = it & 255;
    int qt = ((bg >> 1) & 1) ? 255 - qtr : qtr;
    int b = bg >> 2, g = bg & 3;
    int q0 = qt * 32, t = q0 + qi, hq = g * 4 + wave;
    long tg = (long)b * S_ + t;
    bf16x8 qf[4];
    {
      const bf16_t* qptr = p.Qn + tg * 1024 + hq * 64 + hf * 8;
#pragma unroll
      for (int kk = 0; kk < 4; kk++) qf[kk] = *(const bf16x8*)(qptr + kk * 16);
    }
    const float* gp = p.gate + tg * 48 + hq * 3;
    float g0 = gp[0], g1 = gp[1], g2 = gp[2];
    __syncthreads();
    for (int i = tid; i < 32 * 129; i += 256) sImp[i] = 0u;
    if (tid < 128) sSel[tid] = 0u;
    if (tid < 4) sAny[tid] = 0u;
    unsigned outp[2][8];
#pragma unroll
    for (int di = 0; di < 2; di++)
#pragma unroll
      for (int j = 0; j < 8; j++) outp[di][j] = 0u;
    {
      const bf16_t* Kg = p.Kc + (long)bg * 512 * 64;
      const bf16_t* VTg = p.VcT + (long)bg * 64 * 512;
      int nmax = 2 * qt;
      if (nmax > 510) nmax = 510;
      int ntc = (nmax >> 7) + 1;
      int nlim = (t - 31) >> 4;
      if (nlim > 510) nlim = 510;
      const int lane = otid() & 63, qi = lane & 31, hf = lane >> 5;
      float m = -1e30f, l = 0.f;
#pragma unroll 1
      for (int kt = 0; kt < ntc; kt++) {
        __syncthreads();
        stage_K(Kg + (long)kt * 128 * 64, sK);
        __syncthreads();
#pragma unroll 1
        for (int half = 0; half < 2; half++) {
          f32x16 st[2];
          attn_qk(sK + half * 64 * LSTR, qf, st, lane);
          float mx = -1e30f;
          const int rel = nlim - (kt * 128 + half * 64 + hf * 4);
#pragma unroll
          for (int mi = 0; mi < 2; mi++)
#pragma unroll
            for (int r = 0; r < 16; r++) {
              const int cr = mi * 32 + (r >> 2) * 8 + (r & 3);
              bool valid = (cr <= rel);
              float sv = valid ? st[mi][r] : -1e30f;
              st[mi][r] = sv;
              mx = fmaxf(mx, sv);
            }
          mx = fmaxf(mx, __shfl_xor(mx, 32));
          float mnew = fmaxf(m, mx);
          float ls = 0.f;
#pragma unroll
          for (int mi = 0; mi < 2; mi++)
#pragma unroll
            for (int r = 0; r < 16; r++) {
              float sv = st[mi][r];
              ls += (sv > -1e29f) ? ex2(sv - mnew) : 0.f;
            }
          l = l * ex2(m - mnew) + ls;
          m = mnew;
        }
      }
      float lt = l + __shfl_xor(l, 32);
      float inv = lt > 0.f ? 1.f / lt : 0.f;
      f32x16 o[2];
#pragma unroll
      for (int di = 0; di < 2; di++)
#pragma unroll
        for (int r = 0; r < 16; r++) o[di][r] = 0.f;
#pragma unroll 1
      for (int kt = 0; kt < ntc; kt++) {
        __syncthreads();
        stage_K(Kg + (long)kt * 128 * 64, sK);
        stage_VT(VTg + (long)kt * 128, 512, sV);
        __syncthreads();
#pragma unroll 1
        for (int half = 0; half < 2; half++) {
          f32x16 st[2];
          attn_qk(sK + half * 64 * LSTR, qf, st, lane);
          const int rel = nlim - (kt * 128 + half * 64 + hf * 4);
#pragma unroll
          for (int mi = 0; mi < 2; mi++)
#pragma unroll
            for (int rq = 0; rq < 4; rq++) {
              int nb = kt * 128 + half * 64 + mi * 32 + rq * 8 + hf * 4;
              float pv[4];
#pragma unroll
              for (int j = 0; j < 4; j++) {
                const int cr = mi * 32 + rq * 8 + j;
                bool valid = (cr <= rel);
                pv[j] = valid ? ex2(st[mi][rq * 4 + j] - m) * inv : 0.f;
                st[mi][rq * 4 + j] = pv[j];
              }
              float mainv = pv[0] + pv[1] + pv[2] + 0.5f * pv[3];
              float spill = 0.5f * pv[3];
              int j = nb >> 2;
              if (mainv > 0.f) atomicAdd(&sImp[qi * 129 + j], (unsigned)(mainv * 67108864.f + 0.5f));
              if (spill > 0.f && j + 1 < 128) atomicAdd(&sImp[qi * 129 + j + 1], (unsigned)(spill * 67108864.f + 0.5f));
            }
          attn_pv(sV + half * 64, st, o, lane);
        }
      }
      add_out(outp, o, g0);
    }
    __syncthreads();
    for (int idx = otid(); idx < 32 * 128; idx += 256) {
      int q = idx >> 7, j = idx & 127;
      int tq = q0 + q, cur = tq >> 6;
      bool avail = (j * 64 <= tq);
      bool forced = (j == 0) || (j == cur) || (j == cur - 1);
      unsigned v = sImp[q * 129 + j];
      sImp[q * 129 + j] = avail ? ((forced ? 0x80000000u : 0u) | ((v >> 6) << 8) | (unsigned)(128 - j)) : 0u;
    }
    __syncthreads();
    {
      const int tid2 = otid();
      int q = tid2 >> 3, jg = tid2 & 7;
      unsigned myk[16];
#pragma unroll
      for (int i = 0; i < 16; i++) myk[i] = sImp[q * 129 + jg + 8 * i];
      unsigned thr = 0u;
#pragma unroll 1
      for (int bit = 31; bit >= 0; bit--) {
        unsigned cand = thr | (1u << bit);
        int cnt = 0;
#pragma unroll
        for (int i = 0; i < 16; i++) cnt += (myk[i] >= cand) ? 1 : 0;
        cnt += __shfl_xor(cnt, 1);
        cnt += __shfl_xor(cnt, 2);
        cnt += __shfl_xor(cnt, 4);
        if (cnt >= 16) thr = cand;
      }
      unsigned bits[4] = {0u, 0u, 0u, 0u};
#pragma unroll
      for (int i = 0; i < 16; i++) {
        int j = jg + 8 * i;
        if (myk[i] >= thr && myk[i] != 0u) bits[i >> 2] |= 1u << (jg + 8 * (i & 3));
      }
#pragma unroll
      for (int w = 0; w < 4; w++)
        if (bits[w]) atomicOr(&sSel[q * 4 + w], bits[w]);
    }
    __syncthreads();
#pragma unroll 1
    for (int mode = 1; mode <= 2; mode++) {
      int lo = 0;
      if (mode == 2) {
        lo = q0 - 511;
        if (lo < 0) lo = 0;
        lo >>= 7;
      }
      flash_branch(mode, p.kvbuf + (long)(2 * mode) * partsz + (long)bg * S_ * 64, p.kvbuf + (long)(2 * mode + 1) * partsz + (long)bg * 64 * S_, lo,
                   (q0 + 31) >> 7, qf, t, q0, sSel + qi * 4, mode == 1 ? g1 : g2, outp, sK, sV, lane);
    }
    {
      bf16_t* dst = p.Oattn + tg * 1024 + hq * 64;
#pragma unroll
      for (int di = 0; di < 2; di++)
#pragma unroll
        for (int rq = 0; rq < 4; rq++) {
          int d = di * 32 + rq * 8 + hf * 4;
          *(uint2*)(dst + d) = make_uint2(outp[di][rq * 2], outp[di][rq * 2 + 1]);
        }
    }
  }
}


#define XB_TMO      128
#define XB_XCNT(j)  (256  + 64 * (j))
#define XB_XSUB(j)  (1280 + 64 * (j))
#define XB_XGEN(j)  (2304 + 64 * (j))
#define XB_TOP      3328
#define XB_TOPGEN   3392
#define XCD_BAR_WORDS 3456
#define XB_SPIN_CAP (1u << 22)
#define LAS __attribute__((address_space(3)))
__device__ __forceinline__ unsigned xb_ld(unsigned* p) { return __hip_atomic_load(p, __ATOMIC_RELAXED, __HIP_MEMORY_SCOPE_AGENT); }
__device__ __forceinline__ unsigned xb_add(unsigned* p, unsigned v) { return __hip_atomic_fetch_add(p, v, __ATOMIC_RELAXED, __HIP_MEMORY_SCOPE_AGENT); }
__device__ __forceinline__ unsigned xb_xcc_id() { return (unsigned)__builtin_amdgcn_s_getreg((3 << 11) | 20) & 0xFu; }
#define XB_SPIN(cond, bar) do { unsigned _sp = 0; while (cond) { __builtin_amdgcn_s_sleep(1); \
    if ((++_sp & 255u) == 0u) { if (xb_ld(&(bar)[XB_TMO])) break; if (_sp > XB_SPIN_CAP) { atomicAdd(&(bar)[XB_TMO], 1u); break; } } } } while (0)
struct XcdBarrier { unsigned* bar; unsigned x; volatile LAS unsigned* st; };
__device__ __forceinline__ XcdBarrier xcd_barrier_post(unsigned* bar, volatile LAS unsigned* st) {
  XcdBarrier b; b.bar = bar; b.x = xb_xcc_id(); b.st = st;
  if (threadIdx.x == 0) (void)xb_add(&bar[XB_XCNT(b.x)], 1u);
  return b;
}
__device__ __forceinline__ void xcd_barrier_complete(unsigned* bar, unsigned x, unsigned& nloc, unsigned& nx) {
  const unsigned G = gridDim.x * gridDim.y * gridDim.z;
  unsigned sum, cnt, mine, sp = 0u;
  for (;;) {
    sum = 0u; cnt = 0u; mine = 0u;
#pragma unroll
    for (unsigned j = 0; j < 16; ++j) { const unsigned c = xb_ld(&bar[XB_XCNT(j)]); sum += c; cnt += (c > 0u) ? 1u : 0u; mine = (j == x) ? c : mine; }
    if (sum == G) break;
    __builtin_amdgcn_s_sleep(1);
    if ((++sp & 255u) == 0u) { if (xb_ld(&bar[XB_TMO])) break; if (sp > XB_SPIN_CAP) { atomicAdd(&bar[XB_TMO], 1u); break; } }
  }
  nloc = mine > 0u ? mine : 1u; nx = cnt > 0u ? cnt : 1u;
}
__device__ __forceinline__ void xcd_barrier(const XcdBarrier& b) {
  asm volatile("s_waitcnt vmcnt(0)" ::: "memory");
  __syncthreads();
  if (threadIdx.x == 0) {
    unsigned* bar = b.bar;
    __builtin_amdgcn_s_waitcnt(0);
    unsigned nloc = b.st[0], nx = b.st[1];
    if (nloc == 0u) { xcd_barrier_complete(bar, b.x, nloc, nx); b.st[0] = nloc; b.st[1] = nx; }
    const unsigned old = xb_add(&bar[XB_XSUB(b.x)], 1u);
    const unsigned gen = old / nloc;
    if (old + 1u == (gen + 1u) * nloc) {
      __builtin_amdgcn_fence(__ATOMIC_RELEASE, "agent");
      asm volatile("s_waitcnt vmcnt(0)" ::: "memory");
      const unsigned og = xb_add(&bar[XB_TOP], 1u);
      const unsigned tg = og / nx;
      if (og + 1u == (tg + 1u) * nx) xb_add(&bar[XB_TOPGEN], 1u);
      else XB_SPIN(xb_ld(&bar[XB_TOPGEN]) == tg, bar);
      __builtin_amdgcn_fence(__ATOMIC_ACQUIRE, "agent");
      xb_add(&bar[XB_XGEN(b.x)], 1u);
      asm volatile("s_waitcnt vmcnt(0)" ::: "memory");
    } else {
      XB_SPIN(xb_ld(&bar[XB_XGEN(b.x)]) == gen, bar);
      __builtin_amdgcn_fence(__ATOMIC_ACQUIRE, "agent");
      asm volatile("s_waitcnt vmcnt(0)" ::: "memory");
    }
  }
  __syncthreads();
}

__global__ void __launch_bounds__(256, 2) mk(P p, int lo, int hi) {
  __shared__ __attribute__((aligned(16))) unsigned char smem[SMEM_BYTES];
  cg::grid_group grid = cg::this_grid();
  __shared__ uint4 xb_words;
  if (threadIdx.x == 0) xb_words = make_uint4(0u, 0u, 0u, 0u);
  __syncthreads();
  const XcdBarrier xb = xcd_barrier_post(p.bar, (volatile LAS unsigned*)&xb_words);
  int ph = 0;
#define RUN(stmt)                                   \
  {                                                 \
    if (ph >= lo && ph < hi) { stmt; }              \
    ph++;                                           \
    if (ph > lo && ph < hi) {                       \
      if (lo < 0) grid.sync();   xcd_barrier(xb); \
    }                                               \
  }
#define RUNX(id, stmt)                                           \
  {                                                              \
    if (ph >= lo && ph < hi) { stmt; if (PROBE_ID == id) { stmt; } } \
    ph++;                                                        \
    if (ph > lo && ph < hi) {                                    \
      if (lo < 0) grid.sync();   xcd_barrier(xb);            \
    }                                                            \
  }
  RUNX(1, prep_phase(p, smem));
  RUNX(2, h0_phase(p));
  for (int layer = 0; layer < 4; layer++) {
    if (layer < 2) {
      RUNX(3, ret_proj_phase(p, layer, smem));
      RUNX(4, ret_up_phase(p, smem));
      RUN(ret_scan_phase(p));
      RUNX(6, ret_out_phase(p, smem));
      RUN(ret_gn_phase(p));
      RUN(wo_phase(p, layer, p.Gs, p.retWoT + (long)layer * 1024 * 2048, 2048, smem));
    } else {
      if (layer == 3) { RUNX(16, nsa_q_phase(p, 1, smem)); }
      RUNX(17, nsa_attn_phase(p, smem));
      RUN(wo_phase(p, layer, p.Oattn, p.nsaWoT + (long)(layer - 2) * 1024 * 1024, 1024, smem));
    }
    RUN(ln1_phase(p, layer));
    RUNX(10, peer_qscore_phase(p, layer, smem));
    {
      if (PROBE_ID == 12 && ph >= lo && ph < hi) peer_expert_phase(p, layer, smem, true);
      RUN(peer_expert_phase(p, layer, smem, false));
    }
    if (layer == 1) {
      RUNX(13, kv_proj_phase(p, smem));
      RUN({ cmp1_phase(p, smem); nsa_q_phase(p, 0, smem); });
      RUNX(15, cmp2_phase(p, smem));
    }
  }
}
#define NPHASES (2 + 2 * 6 + 5 + 4 * 3 + 3)

extern "C" void kernel_launch(void* const* d_in, const int* in_sizes, int n_in, void* d_out, int out_size, void* d_ws,
                              size_t ws_size, hipStream_t stream) {
  static int grid_blocks = 0;
  if (!grid_blocks) {
    int dev = 0, cus = 0, per_cu = 0;
    hipGetDevice(&dev);
    hipDeviceGetAttribute(&cus, hipDeviceAttributeMultiprocessorCount, dev);
    hipOccupancyMaxActiveBlocksPerMultiprocessor(&per_cu, mk, 256, 0);
    if (per_cu > 2) per_cu = 2;
    if (per_cu < 1) per_cu = 1;
    grid_blocks = cus * per_cu;
  }
  P p{};
  const float** fin = (const float**)&p;
  for (int i = 0; i < 21; i++) fin[i] = (const float*)d_in[i];
  p.out = (float*)d_out;
  size_t off = 0;
  auto alloc = [&](size_t bytes) {
    void* r = (char*)d_ws + off;
    off += (bytes + 255) & ~(size_t)255;
    return r;
  };
  p.retWinT = (bf16_t*)alloc(2UL * 6144 * 1024 * 2);
  p.retWoT = (bf16_t*)alloc(2UL * 1024 * 2048 * 2);
  p.kvWT = (bf16_t*)alloc(1536UL * 1024 * 2);
  p.w1T = (bf16_t*)alloc(2UL * 256 * 2048 * 2);
  p.w2T = (bf16_t*)alloc(2UL * 128 * 256 * 2);
  p.nsaWinT = (bf16_t*)alloc(2UL * 1152 * 1024 * 2);
  p.nsaWoT = (bf16_t*)alloc(2UL * 1024 * 1024 * 2);
  p.wqT = (bf16_t*)alloc(4UL * 2048 * 1024 * 2);
  p.keysB = (bf16_t*)alloc(4UL * 16 * 128 * 128 * 2);
  p.uB = (unsigned char*)alloc(4UL * 16384 * 2048);
  p.vB = p.uB + 1024;
  p.su = (float*)alloc(4UL * 16384 * 4);
  p.sv = (float*)alloc(4UL * 16384 * 4);
  p.mods = (float*)alloc(4UL * 2 * 6144 * 4);
  p.kvmod = (float*)alloc(2UL * 2048 * 4);
  p.cs = (float*)alloc(8192UL * 128 * 2 * 4);
  p.biasp = (float*)alloc(512 * 4);
  p.bar = (unsigned*)alloc(XCD_BAR_WORDS * 4);
  p.xbuf = (float*)alloc((size_t)T_ * 1024 * 4);
  p.hbuf = (bf16_t*)alloc((size_t)T_ * 1024 * 2);
  p.xsbuf = (bf16_t*)alloc((size_t)T_ * 1024 * 2);
  p.kvbuf = (bf16_t*)alloc(6UL * 8 * S_ * 64 * 2 + 65536);
  p.Kc = (bf16_t*)alloc(8UL * 512 * 64 * 2);
  p.VcT = (bf16_t*)alloc(8UL * 64 * 512 * 2);
  size_t arena = off;
  p.Qd = (bf16_t*)alloc(8UL * S_ * 256 * 2);
  p.Kd = (bf16_t*)alloc(8UL * S_ * 256 * 2);
  p.KdT = (bf16_t*)alloc(8UL * 256 * S_ * 2);
  p.VT = (bf16_t*)alloc(8UL * 512 * S_ * 2);
  p.Gs = (bf16_t*)alloc((size_t)T_ * 2048 * 2);
  p.ST = (bf16_t*)alloc(8UL * 64 * 512 * 256 * 2);
  p.Pb = (bf16_t*)alloc(8UL * 64 * 128 * 128 * 2);
  p.Ob = (bf16_t*)alloc((size_t)T_ * 2048 * 2);
  size_t end_ret = off;
  off = arena;
  p.qp = (bf16_t*)alloc((size_t)T_ * 2048 * 2);
  p.topk = (int*)alloc((size_t)T_ * 16 * 16 * 4);
  p.Qn = (bf16_t*)alloc((size_t)T_ * 1024 * 2);
  p.gate = (float*)alloc((size_t)T_ * 48 * 4);
  p.Oattn = (bf16_t*)alloc((size_t)T_ * 1024 * 2);
  p.hid = (bf16_t*)alloc(16UL * 512 * 256 * 2);
  size_t end_other = off;
  size_t need = end_ret > end_other ? end_ret : end_other;
  if (need > ws_size) {
    fprintf(stderr, "workspace too small: need %zu have %zu\n", need, ws_size);
    return;
  }
#if MULTI_LAUNCH
  for (int ph = 0; ph < NPHASES; ph++) {
    hipLaunchKernelGGL(mk, dim3(grid_blocks), dim3(256), 0, stream, p, ph, ph + 1);
  }
#else
  hipMemsetAsync(p.bar, 0, XCD_BAR_WORDS * 4, stream);
  int lo = 0, hi = NPHASES;
  void* args[] = {&p, &lo, &hi};
  hipError_t e = hipLaunchCooperativeKernel((void*)mk, dim3(grid_blocks), dim3(256), args, 0, stream);
  if (e != hipSuccess) fprintf(stderr, "cooperative launch failed: %s (grid %d)\n", hipGetErrorString(e), grid_blocks);
#endif
}
```
